# Optimizing an MI355X kernel written in HIP

```python
import jax, jax.numpy as jnp
from jax import lax
import numpy as np

D_MODEL = 1024
BATCH = 4
SEQ = 4096
DEPTH = 2

GRID_W = 64
CTX_LEN = 256
D_MIX = D_MODEL
HEAD_DIM = 64
A_WIDTH = D_MIX // 4
A_GROUPS = A_WIDTH // HEAD_DIM
CHUNK = 128
B_WIDTH = D_MIX // 4
POOL_WINDOWS = (2, 4, 8, 16)
B_GROUPS = len(POOL_WINDOWS)
B_GROUP_DIM = B_WIDTH // B_GROUPS
C_WIDTH = D_MIX - A_WIDTH - B_WIDTH
C_HEADS = C_WIDTH // HEAD_DIM
NA_ROWS_MAX = 8
NA_COLS = 16
ATTN_SCALE = HEAD_DIM ** -0.5
AV_OFF = A_WIDTH
B_OFF = 2 * A_WIDTH
CQ_OFF = B_OFF + B_WIDTH
CK_OFF = CQ_OFF + C_WIDTH
CV_OFF = CK_OFF + C_WIDTH
IN_COLS = CV_OFF + C_WIDTH
IN_SPLITS = [AV_OFF, B_OFF, CQ_OFF, CK_OFF, CV_OFF]
D_FF = 2816
N_EXPERTS = 8
TOP_K = 2
D_FF_EXPERT = 3584
N_DENSE = (DEPTH + 1) // 2
N_MOE = DEPTH // 2
EPS = 1e-6
NEG_INF = -1e30

kernel_name = 'hybrid_pool_sgu_natten_moe_dit'


def rms_norm(x, g):
    xf = x.astype(jnp.float32)
    y = xf * lax.rsqrt(jnp.mean(xf * xf, axis=-1, keepdims=True) + EPS)
    return (y * g.astype(jnp.float32)).astype(x.dtype)


def layer_norm(x, g, b):
    xf = x.astype(jnp.float32)
    xc = xf - jnp.mean(xf, axis=-1, keepdims=True)
    var = jnp.mean(xc * xc, axis=-1, keepdims=True)
    y = xc * lax.rsqrt(var + EPS) * g.astype(jnp.float32) + b.astype(jnp.float32)
    return y.astype(x.dtype)


def modulation(cond, w_mod, b_mod):
    m = jax.nn.silu(cond) @ w_mod + b_mod
    return jnp.split(m, 6, axis=-1)


def split_heads(t):
    return t.reshape(t.shape[:-1] + (C_HEADS, HEAD_DIM))


def chunk_sgu(u, v, vn_g, vn_b, w_s, b_s):
    bsz, n_tok, _ = u.shape
    n_chunks = n_tok // CHUNK
    u = jax.nn.gelu(u, approximate=False)
    v = layer_norm(jax.nn.gelu(v, approximate=False), vn_g, vn_b)
    v = v.reshape(bsz, n_chunks, CHUNK, A_GROUPS, HEAD_DIM)
    mixed = jnp.einsum('gij,bnjgd->bnigd', w_s, v) + b_s.T[:, :, None]
    return u * mixed.reshape(bsz, n_tok, A_WIDTH)


def multiscale_pool(z, w_pool, scale):
    bsz, n_tok, _ = z.shape
    zf = z.reshape(bsz, n_tok, B_GROUPS, B_GROUP_DIM).astype(jnp.float32)
    csum = jnp.pad(jnp.cumsum(zf, axis=1), ((0, 0), (1, 0), (0, 0), (0, 0)))
    pos = jnp.arange(n_tok)
    means = []
    for gi, win in enumerate(POOL_WINDOWS):
        lo = jnp.clip(pos - win // 2, 0, n_tok)
        hi = jnp.clip(pos + win // 2, 0, n_tok)
        cnt = (hi - lo).astype(jnp.float32)
        cg = csum[:, :, gi]
        means.append((cg[:, hi] - cg[:, lo]) / cnt[None, :, None])
    pooled = jnp.stack(means, axis=2)
    y = (pooled - zf).astype(z.dtype)
    y = jnp.einsum('blgd,gde->blge', y, w_pool)
    return y.reshape(bsz, n_tok, B_WIDTH) * scale


def neighbourhood_attention(q, k, v, k_ctx, v_ctx, rpb):
    bsz, n_tok = q.shape[:2]
    rows = n_tok // GRID_W
    kh = min(NA_ROWS_MAX, rows)
    r = jnp.arange(rows)
    row_idx = jnp.clip(r - kh // 2, 0, rows - kh)[:, None] + jnp.arange(kh)[None, :]
    row_off = row_idx - r[:, None] + (NA_ROWS_MAX - 1)
    col = jnp.arange(GRID_W)
    col_start = jnp.clip(col - NA_COLS // 2, 0, GRID_W - NA_COLS)
    col_in = (col[None, :] >= col_start[:, None]) & (col[None, :] < col_start[:, None] + NA_COLS)
    col_off = jnp.clip(col[None, :] - col[:, None], -(NA_COLS - 1), NA_COLS - 1) + (NA_COLS - 1)
    bias = rpb[:, row_off[:, None, :, None], col_off[None, :, None, :]].astype(jnp.float32)
    bias = jnp.where(col_in[None, None, :, None, :], bias, NEG_INF)
    bias = jnp.transpose(bias, (1, 0, 2, 3, 4))
    grid_shape = (bsz, rows, GRID_W, C_HEADS, HEAD_DIM)
    qg = q.reshape(grid_shape)
    kg = jnp.take(k.reshape(grid_shape), row_idx, axis=1)
    vg = jnp.take(v.reshape(grid_shape), row_idx, axis=1)
    n_loc = kh * GRID_W
    s_loc = jnp.einsum('brqhd,brikhd->brhqik', qg, kg).astype(jnp.float32) * ATTN_SCALE + bias
    s_ctx = jnp.einsum('brqhd,bchd->brhqc', qg, k_ctx).astype(jnp.float32) * ATTN_SCALE
    s = jnp.concatenate([s_loc.reshape(bsz, rows, C_HEADS, GRID_W, n_loc), s_ctx], axis=-1)
    p = jax.nn.softmax(s, axis=-1).astype(v.dtype)
    p_loc = p[..., :n_loc].reshape(bsz, rows, C_HEADS, GRID_W, kh, GRID_W)
    o = (jnp.einsum('brhqik,brikhd->brqhd', p_loc, vg)
         + jnp.einsum('brhqc,bchd->brqhd', p[..., n_loc:], v_ctx))
    return o.reshape(bsz, n_tok, C_WIDTH)


def context_attention(q_ctx, k_ctx, v_ctx):
    bsz, n_ctx = q_ctx.shape[:2]
    s = jnp.einsum('bqhd,bkhd->bhqk', q_ctx, k_ctx).astype(jnp.float32) * ATTN_SCALE
    p = jax.nn.softmax(s, axis=-1).astype(v_ctx.dtype)
    return jnp.einsum('bhqk,bkhd->bqhd', p, v_ctx).reshape(bsz, n_ctx, C_WIDTH)


def swiglu(h, w_gate, w_up, w_down):
    return (jax.nn.silu(h @ w_gate) * (h @ w_up)) @ w_down


def moe_swiglu(h, w_router, w_gate, w_up, w_down):
    logits = (h @ w_router).astype(jnp.float32)
    top_vals, top_idx = lax.top_k(logits, TOP_K)
    gates = jax.nn.softmax(top_vals, axis=-1)
    dense_gates = jnp.sum(jax.nn.one_hot(top_idx, N_EXPERTS, dtype=jnp.float32) * gates[..., None], axis=-2)
    dense_gates = dense_gates.astype(h.dtype)
    y = jnp.zeros_like(h)
    for e in range(N_EXPERTS):
        y = y + dense_gates[..., e:e + 1] * swiglu(h, w_gate[e], w_up[e], w_down[e])
    return y


def setup_inputs(seed: int = 0) -> dict:
    key = jax.random.key(seed)
    ks = jax.random.split(key, 26)
    f32 = jnp.float32

    def nrm(k, shape, s):
        return jax.random.normal(k, shape, f32) * s

    L = DEPTH
    return {
        'x': nrm(ks[0], (BATCH, SEQ, D_MODEL), 1.0),
        'c': nrm(ks[1], (BATCH, D_MODEL), 1.0),
        'ctx': nrm(ks[2], (BATCH, CTX_LEN, D_MODEL), 1.0),
        'c_ctx': nrm(ks[3], (D_MODEL,), 1.0),
        'w_mod': nrm(ks[4], (L, D_MODEL, 6 * D_MODEL), 0.5 * D_MODEL ** -0.5),
        'b_mod': nrm(ks[5], (L, 6 * D_MODEL), 0.02),
        'norm1_g': 1.0 + nrm(ks[6], (L, D_MODEL), 0.01),
        'norm2_g': 1.0 + nrm(ks[7], (L, D_MODEL), 0.01),
        'w_in': nrm(ks[8], (L, D_MODEL, IN_COLS), D_MODEL ** -0.5),
        'w_out': nrm(ks[9], (L, D_MIX, D_MODEL), D_MIX ** -0.5),
        'a_vn_g': 1.0 + nrm(ks[10], (L, A_WIDTH), 0.01),
        'a_vn_b': nrm(ks[11], (L, A_WIDTH), 0.01),
        'a_ws': nrm(ks[12], (L, A_GROUPS, CHUNK, CHUNK), CHUNK ** -0.5),
        'a_bs': 1.0 + nrm(ks[13], (L, A_GROUPS, CHUNK), 0.01),
        'b_wpool': nrm(ks[14], (L, B_GROUPS, B_GROUP_DIM, B_GROUP_DIM), B_GROUP_DIM ** -0.5),
        'b_scale': 1.0 + nrm(ks[15], (L, B_WIDTH), 0.01),
        'c_qn_g': 1.0 + nrm(ks[16], (L, HEAD_DIM), 0.01),
        'c_kn_g': 1.0 + nrm(ks[17], (L, HEAD_DIM), 0.01),
        'c_rpb': nrm(ks[18], (L, C_HEADS, 2 * NA_ROWS_MAX - 1, 2 * NA_COLS - 1), 0.02),
        'ffn_w_gate': nrm(ks[19], (N_DENSE, D_MODEL, D_FF), D_MODEL ** -0.5),
        'ffn_w_up': nrm(ks[20], (N_DENSE, D_MODEL, D_FF), D_MODEL ** -0.5),
        'ffn_w_down': nrm(ks[21], (N_DENSE, D_FF, D_MODEL), D_FF ** -0.5),
        'moe_w_router': nrm(ks[22], (N_MOE, D_MODEL, N_EXPERTS), D_MODEL ** -0.5),
        'moe_w_gate': nrm(ks[23], (N_MOE, N_EXPERTS, D_MODEL, D_FF_EXPERT), D_MODEL ** -0.5),
        'moe_w_up': nrm(ks[24], (N_MOE, N_EXPERTS, D_MODEL, D_FF_EXPERT), D_MODEL ** -0.5),
        'moe_w_down': nrm(ks[25], (N_MOE, N_EXPERTS, D_FF_EXPERT, D_MODEL), D_FF_EXPERT ** -0.5),
    }


def reference(x, c, ctx, c_ctx, w_mod, b_mod, norm1_g, norm2_g, w_in, w_out,
              a_vn_g, a_vn_b, a_ws, a_bs, b_wpool, b_scale, c_qn_g, c_kn_g, c_rpb,
              ffn_w_gate, ffn_w_up, ffn_w_down,
              moe_w_router, moe_w_gate, moe_w_up, moe_w_down):
    cond_x = c[:, None, :]
    cond_c = c_ctx[None, None, :]
    xc = ctx
    for l in range(DEPTH):
        last = l == DEPTH - 1
        sh1, sc1, ga1, sh2, sc2, ga2 = modulation(cond_x, w_mod[l], b_mod[l])
        csh1, csc1, cga1, csh2, csc2, cga2 = modulation(cond_c, w_mod[l], b_mod[l])
        fi = l // 2

        def channel_mixer(t):
            if l % 2 == 0:
                return swiglu(t, ffn_w_gate[fi], ffn_w_up[fi], ffn_w_down[fi])
            return moe_swiglu(t, moe_w_router[fi], moe_w_gate[fi], moe_w_up[fi], moe_w_down[fi])

        hc = rms_norm(xc, norm1_g[l]) * (1 + csc1) + csh1
        if last:
            kv_c = hc @ w_in[l][:, CK_OFF:]
        else:
            proj_c = hc @ w_in[l]
            kv_c = proj_c[..., CK_OFF:]
        k_c = rms_norm(split_heads(kv_c[..., :C_WIDTH]), c_kn_g[l])
        v_c = split_heads(kv_c[..., C_WIDTH:])

        h = rms_norm(x, norm1_g[l]) * (1 + sc1) + sh1
        u, v, zb, q, k, vv = jnp.split(h @ w_in[l], IN_SPLITS, axis=-1)
        q = rms_norm(split_heads(q), c_qn_g[l])
        k = rms_norm(split_heads(k), c_kn_g[l])
        vv = split_heads(vv)
        mix = jnp.concatenate([
            chunk_sgu(u, v, a_vn_g[l], a_vn_b[l], a_ws[l], a_bs[l]),
            multiscale_pool(zb, b_wpool[l], b_scale[l]),
            neighbourhood_attention(q, k, vv, k_c, v_c, c_rpb[l]),
        ], axis=-1)
        x_new = x + ga1 * (mix @ w_out[l])
        h2 = rms_norm(x_new, norm2_g[l]) * (1 + sc2) + sh2
        x_new = x_new + ga2 * channel_mixer(h2)

        if not last:
            uc, vcm, zc, qc = jnp.split(proj_c[..., :CK_OFF], [AV_OFF, B_OFF, CQ_OFF], axis=-1)
            qc = rms_norm(split_heads(qc), c_qn_g[l])
            mix_c = jnp.concatenate([
                chunk_sgu(uc, vcm, a_vn_g[l], a_vn_b[l], a_ws[l], a_bs[l]),
                multiscale_pool(zc, b_wpool[l], b_scale[l]),
                context_attention(qc, k_c, v_c),
            ], axis=-1)
            xc = xc + cga1 * (mix_c @ w_out[l])
            h2c = rms_norm(xc, norm2_g[l]) * (1 + csc2) + csh2
            xc = xc + cga2 * channel_mixer(h2c)
        x = x_new
    return x
```

```cpp
#include <hip/hip_runtime.h>
#include <cstdio>
#include <cstdint>
#include <cmath>

namespace nv {
constexpr int D = 1024, BATCH = 4, SEQ = 4096, CTX = 256, DEPTH = 2;
constexpr int NLAT = BATCH * SEQ, NCTX = BATCH * CTX, R = NLAT + NCTX;
constexpr int INC = 2304, AW = 256, BW = 256, CW = 512, HD = 64, NH = 8;
constexpr int OFF_U = 0, OFF_V = 256, OFF_Z = 512, OFF_Q = 768, OFF_K = 1280, OFF_VV = 1792;
constexpr int DFF = 2816, NE = 8, DFE = 3584;
constexpr float EPS = 1e-6f;

__device__ __forceinline__ int cond_of(int row) { return row < NLAT ? row / SEQ : 4; }
__device__ __forceinline__ float silu_f(float x) { return x / (1.f + expf(-x)); }
__device__ __forceinline__ float gelu_f(float x) { return 0.5f * x * (1.f + erff(x * 0.70710678118654752f)); }

__global__ void k_mod(const float* c, const float* c_ctx, const float* w_mod, const float* b_mod, float* mod) {
    const int n = blockIdx.x * 256 + threadIdx.x, l = blockIdx.y;
    __shared__ float sc[5][D];
    for (int i = threadIdx.x; i < 5 * D; i += 256) { const int cd = i / D, k = i % D; const float v = cd < 4 ? c[cd * D + k] : c_ctx[k]; sc[cd][k] = silu_f(v); }
    __syncthreads();
    float a[5] = {0, 0, 0, 0, 0};
    const float* w = w_mod + (size_t)l * D * 6 * D + n;
    for (int k = 0; k < D; ++k) { const float wv = w[(size_t)k * 6 * D];
#pragma unroll
        for (int cd = 0; cd < 5; ++cd) a[cd] += sc[cd][k] * wv; }
    const float b = b_mod[l * 6 * D + n];
#pragma unroll
    for (int cd = 0; cd < 5; ++cd) mod[((size_t)l * 5 + cd) * 6 * D + n] = a[cd] + b;
}

__device__ __forceinline__ float block_sum256(float v, float* red) {
#pragma unroll
    for (int o = 32; o > 0; o >>= 1) v += __shfl_xor(v, o);
    __syncthreads();
    if ((threadIdx.x & 63) == 0) red[threadIdx.x >> 6] = v;
    __syncthreads();
    return red[0] + red[1] + red[2] + red[3];
}

__global__ void k_norm_mod(const float* xl, const float* xc, const float* g, const float* modl, int shi, int sci, float* out) {
    __shared__ float red[4];
    const int row = blockIdx.x; const float* x = row < NLAT ? xl + (size_t)row * D : xc + (size_t)(row - NLAT) * D;
    const int cd = cond_of(row); const float* sh = modl + ((size_t)cd * 6 + shi) * D; const float* sc = modl + ((size_t)cd * 6 + sci) * D;
    float v[4]; float s = 0.f;
#pragma unroll
    for (int j = 0; j < 4; ++j) { v[j] = x[threadIdx.x + 256 * j]; s += v[j] * v[j]; }
    const float tot = block_sum256(s, red);
    const float rs = rsqrtf(tot / D + EPS);
#pragma unroll
    for (int j = 0; j < 4; ++j) { const int cidx = threadIdx.x + 256 * j; out[(size_t)row * D + cidx] = v[j] * rs * g[cidx] * (1.f + sc[cidx]) + sh[cidx]; }
}

struct GemmP {
    const float* A; int lda; const int* arow; const int* mcnt; int M; int N; int K;
    const float* B; const float* B2; int ldb;
    float* C; int ldc;
    const float* rl; const float* rc; float* cl; float* cc;
    const float* gate; int gi;
    const float* rowgate; const int* otok;
};
template <int MODE, bool DUAL>
__global__ void __launch_bounds__(256) k_gemm(GemmP p) {
    const int M = p.mcnt ? *p.mcnt : p.M;
    const int m0 = blockIdx.y * 64, n0 = blockIdx.x * 64;
    if (m0 >= M) return;
    __shared__ float As[16][65], Bs[16][64], Bs2[DUAL ? 16 : 1][64];
    const int tx = threadIdx.x & 15, ty = threadIdx.x >> 4;
    float acc[4][4] = {}, acc2[4][4] = {};
    const int ar = threadIdx.x >> 2, ak = (threadIdx.x & 3) * 4;
    int arow = m0 + ar; const bool avalid = arow < M; if (!avalid) arow = 0; else if (p.arow) arow = p.arow[arow];
    const float* Ap = p.A + (size_t)arow * p.lda + ak;
    const int bk = threadIdx.x >> 4, bn = (threadIdx.x & 15) * 4;
    for (int k0 = 0; k0 < p.K; k0 += 16) {
        const float4 av = avalid ? *(const float4*)(Ap + k0) : make_float4(0, 0, 0, 0);
        As[ak + 0][ar] = av.x; As[ak + 1][ar] = av.y; As[ak + 2][ar] = av.z; As[ak + 3][ar] = av.w;
        *(float4*)&Bs[bk][bn] = *(const float4*)(p.B + (size_t)(k0 + bk) * p.ldb + n0 + bn);
        if (DUAL) *(float4*)&Bs2[bk][bn] = *(const float4*)(p.B2 + (size_t)(k0 + bk) * p.ldb + n0 + bn);
        __syncthreads();
#pragma unroll
        for (int kk = 0; kk < 16; ++kk) {
            float a[4], b[4], b2[4];
#pragma unroll
            for (int i = 0; i < 4; ++i) a[i] = As[kk][ty * 4 + i];
#pragma unroll
            for (int j = 0; j < 4; ++j) { b[j] = Bs[kk][tx * 4 + j]; if (DUAL) b2[j] = Bs2[kk][tx * 4 + j]; }
#pragma unroll
            for (int i = 0; i < 4; ++i)
#pragma unroll
                for (int j = 0; j < 4; ++j) { acc[i][j] += a[i] * b[j]; if (DUAL) acc2[i][j] += a[i] * b2[j]; }
        }
        __syncthreads();
    }
#pragma unroll
    for (int i = 0; i < 4; ++i) {
        const int row = m0 + ty * 4 + i; if (row >= M) continue;
#pragma unroll
        for (int j = 0; j < 4; ++j) {
            const int n = n0 + tx * 4 + j; float v = acc[i][j]; if (DUAL) v = silu_f(v) * acc2[i][j];
            if (MODE == 0) p.C[(size_t)row * p.ldc + n] = v;
            else if (MODE == 1) { const int cd = cond_of(row); const float gt = p.gate[((size_t)cd * 6 + p.gi) * D + n];
                if (row < NLAT) p.cl[(size_t)row * D + n] = p.rl[(size_t)row * D + n] + gt * v;
                else { const size_t o = (size_t)(row - NLAT) * D + n; p.cc[o] = p.rc[o] + gt * v; } }
            else { const int tok = p.otok[row]; const int cd = cond_of(tok); const float gt = p.gate[((size_t)cd * 6 + p.gi) * D + n];
                p.cl[(size_t)tok * D + n] += p.rowgate[row] * gt * v; }
        }
    }
}

__global__ void k_proj_post(float* P, const float* vn_g, const float* vn_b, const float* qn_g, const float* kn_g) {
    __shared__ float red[4];
    float* p = P + (size_t)blockIdx.x * INC; const int t = threadIdx.x;
    p[OFF_U + t] = gelu_f(p[OFF_U + t]);
    const float gv = gelu_f(p[OFF_V + t]);
    const float mean = block_sum256(gv, red) / 256.f; const float dv = gv - mean;
    const float var = block_sum256(dv * dv, red) / 256.f;
    p[OFF_V + t] = dv * rsqrtf(var + EPS) * vn_g[t] + vn_b[t];
#pragma unroll
    for (int part = 0; part < 2; ++part) {
        const int off = part == 0 ? OFF_Q : OFF_K; const float* g = part == 0 ? qn_g : kn_g;
#pragma unroll
        for (int half = 0; half < 2; ++half) {
            const int idx = t + 256 * half; const float v = p[off + idx]; float s = v * v;
#pragma unroll
            for (int o = 32; o > 0; o >>= 1) s += __shfl_xor(s, o);
            p[off + idx] = v * rsqrtf(s / 64.f + EPS) * g[idx & 63];
        }
    }
}

__global__ void k_sgu(const float* P, const float* ws, const float* bs, float* MIX) {
    const int row = blockIdx.x, c = threadIdx.x, g = c >> 6, i = row & 127, cb = row - i;
    const float* w = ws + ((size_t)g * 128 + i) * 128; float a = 0.f;
    for (int j = 0; j < 128; ++j) a += w[j] * P[(size_t)(cb + j) * INC + OFF_V + c];
    MIX[(size_t)row * D + c] = P[(size_t)row * INC + OFF_U + c] * (a + bs[g * 128 + i]);
}
__global__ void k_pool1(const float* P, float* YB) {
    const int row = blockIdx.x, c = threadIdx.x, g = c >> 6, win = 2 << g;
    int s0, n; if (row < NLAT) { s0 = (row / SEQ) * SEQ; n = SEQ; } else { s0 = NLAT + ((row - NLAT) / CTX) * CTX; n = CTX; }
    const int pos = row - s0; int lo = pos - win / 2; if (lo < 0) lo = 0; int hi = pos + win / 2; if (hi > n) hi = n;
    float s = 0.f; for (int t = lo; t < hi; ++t) s += P[(size_t)(s0 + t) * INC + OFF_Z + c];
    YB[(size_t)row * 256 + c] = s / (float)(hi - lo) - P[(size_t)row * INC + OFF_Z + c];
}
__global__ void k_pool2(const float* YB, const float* wp, const float* scale, float* MIX) {
    const int row = blockIdx.x, c = threadIdx.x, g = c >> 6, e = c & 63; float a = 0.f;
    for (int d = 0; d < 64; ++d) a += YB[(size_t)row * 256 + g * 64 + d] * wp[((size_t)g * 64 + d) * 64 + e];
    MIX[(size_t)row * D + 256 + c] = a * scale[c];
}
__global__ void __launch_bounds__(64) k_attn(const float* P, const float* rpb, float* MIX, int nrows) {
    const int idx = blockIdx.x * 64 + threadIdx.x; const int row = idx >> 3, h = idx & 7; if (row >= nrows) return;
    const float* q = P + (size_t)row * INC + OFF_Q + h * 64; float qv[64];
#pragma unroll
    for (int d = 0; d < 64; ++d) qv[d] = q[d];
    const bool lat = row < NLAT; const int b = lat ? row / SEQ : (row - NLAT) / CTX;
    int r = 0, qc = 0, rs = 0, cs = 0;
    if (lat) { const int pos = row - b * SEQ; r = pos >> 6; qc = pos & 63; rs = r - 4; rs = rs < 0 ? 0 : (rs > 56 ? 56 : rs); cs = qc - 8; cs = cs < 0 ? 0 : (cs > 48 ? 48 : cs); }
    const int nloc = lat ? 128 : 0, ntot = nloc + 256;
    float mx = -3.0e38f;
    for (int pass = 0; pass < 2; ++pass) {
        float l = 0.f; float o[64];
#pragma unroll
        for (int d = 0; d < 64; ++d) o[d] = 0.f;
        for (int kidx = 0; kidx < ntot; ++kidx) {
            int krow; float bias = 0.f;
            if (kidx < nloc) { const int i = kidx >> 4, kc = cs + (kidx & 15), kr = rs + i; krow = b * SEQ + kr * 64 + kc;
                int co = kc - qc; co = co < -15 ? -15 : (co > 15 ? 15 : co);
                bias = rpb[((size_t)h * 15 + (kr - r + 7)) * 31 + co + 15]; }
            else krow = NLAT + b * CTX + (kidx - nloc);
            const float* k = P + (size_t)krow * INC + OFF_K + h * 64; float s = 0.f;
#pragma unroll
            for (int d = 0; d < 64; ++d) s += qv[d] * k[d];
            s = s * 0.125f + bias;
            if (pass == 0) mx = fmaxf(mx, s);
            else { const float pe = expf(s - mx); l += pe; const float* v = P + (size_t)krow * INC + OFF_VV + h * 64;
#pragma unroll
                for (int d = 0; d < 64; ++d) o[d] += pe * v[d]; }
        }
        if (pass == 1) { const float inv = 1.f / l; float* out = MIX + (size_t)row * D + 512 + h * 64;
#pragma unroll
            for (int d = 0; d < 64; ++d) out[d] = o[d] * inv; }
    }
}
__global__ void k_route(const float* H2, const float* wr, int* e01, float* g01) {
    const int row = blockIdx.x * 4 + (threadIdx.x >> 6), lane = threadIdx.x & 63; float a[8] = {};
    for (int k = lane; k < D; k += 64) { const float hv = H2[(size_t)row * D + k];
#pragma unroll
        for (int e = 0; e < 8; ++e) a[e] += hv * wr[k * 8 + e]; }
#pragma unroll
    for (int e = 0; e < 8; ++e)
#pragma unroll
        for (int o = 32; o > 0; o >>= 1) a[e] += __shfl_xor(a[e], o);
    if (lane == 0) { int i0 = 0; float v0 = a[0];
#pragma unroll
        for (int e = 1; e < 8; ++e) if (a[e] > v0) { v0 = a[e]; i0 = e; }
        int i1 = -1; float v1 = -3.0e38f;
#pragma unroll
        for (int e = 0; e < 8; ++e) if (e != i0 && a[e] > v1) { v1 = a[e]; i1 = e; }
        const float p1 = expf(v1 - v0); const float g0 = 1.f / (1.f + p1), g1 = p1 / (1.f + p1);
        e01[row * 2] = i0; e01[row * 2 + 1] = i1; g01[row * 2] = g0; g01[row * 2 + 1] = g1; }
}
__global__ void k_lists(const int* e01, const float* g01, int* list, float* lgate, int* cnt) {
    const int e = blockIdx.x, t = threadIdx.x; __shared__ int wsum[16]; __shared__ int base;
    if (t == 0) base = 0; __syncthreads();
    for (int c0 = 0; c0 < NLAT; c0 += 1024) {
        const int tok = c0 + t; const int s0 = e01[tok * 2] == e, s1 = e01[tok * 2 + 1] == e; const int f = s0 | s1;
        const unsigned long long bal = __ballot(f); const int lane = t & 63, w = t >> 6;
        const int pre = __popcll(bal & ((1ull << lane) - 1ull));
        if (lane == 0) wsum[w] = __popcll(bal);
        __syncthreads();
        int wb = 0; for (int i = 0; i < w; ++i) wb += wsum[i];
        int tot = 0; for (int i = 0; i < 16; ++i) tot += wsum[i];
        const int b0 = base;
        if (f) { const int pos = b0 + wb + pre; list[e * NLAT + pos] = tok; lgate[e * NLAT + pos] = s0 ? g01[tok * 2] : g01[tok * 2 + 1]; }
        __syncthreads();
        if (t == 0) base = b0 + tot;
        __syncthreads();
    }
    if (t == 0) cnt[e] = base;
}
}

extern "C" void kernel_launch(void* const* d_in, const int* in_sizes, int n_in, void* d_out, int out_size, void* d_ws, size_t ws_size, hipStream_t stream) {
    using namespace nv;
    const float* x = (const float*)d_in[0]; const float* c = (const float*)d_in[1]; const float* ctx = (const float*)d_in[2]; const float* c_ctx = (const float*)d_in[3];
    const float* w_mod = (const float*)d_in[4]; const float* b_mod = (const float*)d_in[5]; const float* norm1_g = (const float*)d_in[6]; const float* norm2_g = (const float*)d_in[7];
    const float* w_in = (const float*)d_in[8]; const float* w_out = (const float*)d_in[9]; const float* a_vn_g = (const float*)d_in[10]; const float* a_vn_b = (const float*)d_in[11];
    const float* a_ws = (const float*)d_in[12]; const float* a_bs = (const float*)d_in[13]; const float* b_wpool = (const float*)d_in[14]; const float* b_scale = (const float*)d_in[15];
    const float* c_qn_g = (const float*)d_in[16]; const float* c_kn_g = (const float*)d_in[17]; const float* c_rpb = (const float*)d_in[18];
    const float* ffn_wg = (const float*)d_in[19]; const float* ffn_wu = (const float*)d_in[20]; const float* ffn_wd = (const float*)d_in[21];
    const float* moe_wr = (const float*)d_in[22]; const float* moe_wg = (const float*)d_in[23]; const float* moe_wu = (const float*)d_in[24]; const float* moe_wd = (const float*)d_in[25];
    float* out = (float*)d_out;
    constexpr size_t MiB = 1u << 20;
    char* ws = (char*)d_ws;
    float* mod = (float*)(ws + 0);
    int* e01 = (int*)(ws + 1 * MiB); float* g01 = (float*)(ws + 2 * MiB); int* cnt = (int*)(ws + 3 * MiB);
    int* list = (int*)(ws + 4 * MiB); float* lgate = (float*)(ws + 5 * MiB);
    float* H = (float*)(ws + 8 * MiB);
    float* X1 = (float*)(ws + 76 * MiB);
    float* XM = (float*)(ws + 144 * MiB);
    float* YB = (float*)(ws + 212 * MiB);
    float* OV = (float*)(ws + 230 * MiB);
    float* PROJ = OV; float* MIX = (float*)(ws + (230 + 153) * MiB); float* HFF = OV; float* Hc = OV;
    if (ws_size < (size_t)(230 + 224) * MiB) { fprintf(stderr, "ws too small: %zu\n", ws_size); return; }

    k_mod<<<dim3(6 * D / 256, DEPTH), 256, 0, stream>>>(c, c_ctx, w_mod, b_mod, mod);
    for (int l = 0; l < DEPTH; ++l) {
        const bool last = l == DEPTH - 1;
        const float* modl = mod + (size_t)l * 5 * 6 * D;
        const float* xl = l == 0 ? x : X1; const float* xc = l == 0 ? ctx : X1 + (size_t)NLAT * D;
        float* xml = last ? out : XM; float* xmc = XM + (size_t)NLAT * D;
        float* xol = last ? out : X1; float* xoc = X1 + (size_t)NLAT * D;
        k_norm_mod<<<R, 256, 0, stream>>>(xl, xc, norm1_g + l * D, modl, 0, 1, H);
        { GemmP p{}; p.A = H; p.lda = D; p.M = R; p.N = INC; p.K = D; p.B = w_in + (size_t)l * D * INC; p.ldb = INC; p.C = PROJ; p.ldc = INC;
          k_gemm<0, false><<<dim3(INC / 64, R / 64), 256, 0, stream>>>(p); }
        k_proj_post<<<R, 256, 0, stream>>>(PROJ, a_vn_g + l * AW, a_vn_b + l * AW, c_qn_g + l * HD, c_kn_g + l * HD);
        const int nr = last ? NLAT : R;
        k_sgu<<<nr, 256, 0, stream>>>(PROJ, a_ws + (size_t)l * 4 * 128 * 128, a_bs + l * 4 * 128, MIX);
        k_pool1<<<nr, 256, 0, stream>>>(PROJ, YB);
        k_pool2<<<nr, 256, 0, stream>>>(YB, b_wpool + (size_t)l * 4 * 64 * 64, b_scale + l * BW, MIX);
        k_attn<<<(nr * 8 + 63) / 64, 64, 0, stream>>>(PROJ, c_rpb + (size_t)l * NH * 15 * 31, MIX, nr);
        { GemmP p{}; p.A = MIX; p.lda = D; p.M = nr; p.N = D; p.K = D; p.B = w_out + (size_t)l * D * D; p.ldb = D;
          p.rl = xl; p.rc = xc; p.cl = xml; p.cc = xmc; p.gate = modl; p.gi = 2;
          k_gemm<1, false><<<dim3(D / 64, nr / 64), 256, 0, stream>>>(p); }
        k_norm_mod<<<nr, 256, 0, stream>>>(xml, xmc, norm2_g + l * D, modl, 3, 4, H);
        if (l % 2 == 0) {
            const int fi = l / 2;
            { GemmP p{}; p.A = H; p.lda = D; p.M = nr; p.N = DFF; p.K = D; p.B = ffn_wg + (size_t)fi * D * DFF; p.B2 = ffn_wu + (size_t)fi * D * DFF; p.ldb = DFF; p.C = HFF; p.ldc = DFF;
              k_gemm<0, true><<<dim3(DFF / 64, nr / 64), 256, 0, stream>>>(p); }
            { GemmP p{}; p.A = HFF; p.lda = DFF; p.M = nr; p.N = D; p.K = DFF; p.B = ffn_wd + (size_t)fi * DFF * D; p.ldb = D;
              p.rl = xml; p.rc = xmc; p.cl = xol; p.cc = xoc; p.gate = modl; p.gi = 5;
              k_gemm<1, false><<<dim3(D / 64, nr / 64), 256, 0, stream>>>(p); }
        } else {
            const int fi = l / 2;
            k_route<<<NLAT / 4, 256, 0, stream>>>(H, moe_wr + (size_t)fi * D * NE, e01, g01);
            k_lists<<<NE, 1024, 0, stream>>>(e01, g01, list, lgate, cnt);
            for (int e = 0; e < NE; ++e) {
                const size_t wo = ((size_t)fi * NE + e) * D * DFE;
                { GemmP p{}; p.A = H; p.lda = D; p.arow = list + e * NLAT; p.mcnt = cnt + e; p.M = NLAT; p.N = DFE; p.K = D; p.B = moe_wg + wo; p.B2 = moe_wu + wo; p.ldb = DFE; p.C = Hc; p.ldc = DFE;
                  k_gemm<0, true><<<dim3(DFE / 64, NLAT / 64), 256, 0, stream>>>(p); }
                { GemmP p{}; p.A = Hc; p.lda = DFE; p.otok = list + e * NLAT; p.mcnt = cnt + e; p.M = NLAT; p.N = D; p.K = DFE; p.B = moe_wd + wo; p.ldb = D;
                  p.cl = xol; p.gate = modl; p.gi = 5; p.rowgate = lgate + e * NLAT;
                  k_gemm<2, false><<<dim3(D / 64, NLAT / 64), 256, 0, stream>>>(p); }
            }
        }
    }
}
```

```cpp
#include <hip/hip_runtime.h>
#include <cstdio>
#include <cstdint>

#define LAS __attribute__((address_space(3)))
#define GAS __attribute__((address_space(1)))
typedef unsigned short bf16_t;
typedef short bf16x8 __attribute__((ext_vector_type(8)));
typedef short s16x4 __attribute__((ext_vector_type(4)));
typedef float f32x4 __attribute__((ext_vector_type(4)));
typedef float f32x2 __attribute__((ext_vector_type(2)));
typedef unsigned u32x4 __attribute__((ext_vector_type(4)));
typedef unsigned u32x2 __attribute__((ext_vector_type(2)));
typedef GAS unsigned gu32;

constexpr int D = 1024, BATCH = 4, SEQ = 4096, CTX = 256, DEPTH = 2;
constexpr int NLAT = BATCH * SEQ, NCTX = BATCH * CTX, R = NLAT + NCTX;
constexpr int INC = 2304, HD = 64, NH = 8;
constexpr int OFF_U = 0, OFF_V = 256, OFF_Z = 512, OFF_Q = 768, OFF_K = 1280, OFF_VV = 1792;
constexpr int DFF = 2816, NE = 8, DFE = 3584;
constexpr int MAXP = 136;
constexpr float EPS = 1e-6f;
constexpr float L2E = 1.4426950408889634f;

constexpr size_t MiB = 1u << 20;
constexpr size_t WS_CTL = 0, CTL_ZERO_BYTES = 64 * 1024;
constexpr size_t WS_MOD = 1 * MiB;
constexpr size_t WS_E01 = 2 * MiB, WS_G01 = 2 * MiB + 256 * 1024, WS_CNTW = 2 * MiB + 512 * 1024;
constexpr size_t WS_LIST = 3 * MiB, WS_LGATE = 3 * MiB + 256 * 1024, WS_PEXP = 3 * MiB + 512 * 1024;
constexpr size_t WS_WPOOL = 4 * MiB, WS_AWS = 4 * MiB + 512 * 1024;
constexpr size_t WS_WIN = 6 * MiB, WS_WOUT = 15 * MiB, WS_WGU = 19 * MiB, WS_WD = 30 * MiB, WS_MGU = 36 * MiB, WS_MD = 148 * MiB;
constexpr size_t WS_HB = 204 * MiB, WS_XMC = 238 * MiB, WS_XC1 = 242 * MiB, WS_X1 = 246 * MiB, WS_PROJ = 310 * MiB, WS_MIX = 387 * MiB;
constexpr size_t WS_HFF = 310 * MiB;
constexpr size_t WS_HFM = 246 * MiB;
constexpr size_t WS_Y = 36 * MiB;
constexpr size_t WS_END = 484 * MiB;
static_assert(WS_HFM + (size_t)MAXP * 256 * DFE * 2 <= WS_END, "ws map");
static_assert(WS_MIX + (size_t)R * D * 2 <= WS_END && WS_PROJ + (size_t)R * INC * 2 <= WS_MIX && WS_HFF + (size_t)R * DFF * 2 <= WS_END, "ws map");

constexpr int RING_BYTES = 131072;
constexpr int LDSCTL_OFF = RING_BYTES;
constexpr int LDS_BYTES = 147456;
constexpr int NWAVES = 8;

__device__ __forceinline__ float bf2f(unsigned short h) { return __uint_as_float((unsigned)h << 16); }
__device__ __forceinline__ unsigned cvt_pk_bf16(float lo, float hi) { unsigned r; asm volatile("v_cvt_pk_bf16_f32 %0, %1, %2" : "=v"(r) : "v"(lo), "v"(hi)); return r; }
__device__ __forceinline__ float silu_f(float x) { return x * __builtin_amdgcn_rcpf(1.f + __builtin_amdgcn_exp2f(-x * L2E)); }
__device__ __forceinline__ float wave_sum(float v) {
#pragma unroll
    for (int o = 1; o < 64; o <<= 1) v += __shfl_xor(v, o);
    return v;
}
__device__ __forceinline__ f32x2 gelu_pk(f32x2 v) {
    const f32x2 av = __builtin_elementwise_abs(v), d = av * 0.2316418882f + 1.0f;
    f32x2 t; t.x = __builtin_amdgcn_rcpf(d.x); t.y = __builtin_amdgcn_rcpf(d.y);
    f32x2 q = t * 0.5307027145f + (-0.7265760135f); q = q * t + 0.7107068705f; q = q * t + (-0.142248368f); q = q * t + 0.127414796f; q = q * t;
    const f32x2 s = (v * v) * (-0.72134752044f);
    f32x2 e; e.x = __builtin_amdgcn_exp2f(s.x); e.y = __builtin_amdgcn_exp2f(s.y);
    const f32x2 m = v * (q * e), r = v - m;
    f32x2 o; o.x = v.x < 0.f ? m.x : r.x; o.y = v.y < 0.f ? m.y : r.y; return o;
}
__device__ __forceinline__ void unpack8(const u32x4 w, float (&f)[8]) {
    f[0] = __uint_as_float(w.x << 16); f[1] = __uint_as_float(w.x & 0xffff0000u); f[2] = __uint_as_float(w.y << 16); f[3] = __uint_as_float(w.y & 0xffff0000u);
    f[4] = __uint_as_float(w.z << 16); f[5] = __uint_as_float(w.z & 0xffff0000u); f[6] = __uint_as_float(w.w << 16); f[7] = __uint_as_float(w.w & 0xffff0000u);
}

namespace pg8 {
constexpr int BM = 256, BK = 64, HALF = 128, HTB = HALF * BK * 2, STAGE_BYTES = 8 * HTB, NXCD = 8, WGM = 8;
__host__ __device__ __forceinline__ int lds_byte(int r, int c) { const int st = (r >> 4) * 2 + (c >> 5), rr = r & 15, cc = c & 31, ob = rr * 64 + cc * 2; return st * 1024 + (ob ^ (((ob >> 9) & 1) << 5)); }
__host__ __device__ __forceinline__ void stage_rc(int b, int& Rr, int& C) { const int st = b / 1024, sb = b % 1024, swz = sb ^ (((sb >> 9) & 1) << 5); Rr = (st >> 1) * 16 + swz / 64; C = (st & 1) * 32 + (swz % 64) / 2; }
__host__ __device__ __forceinline__ int perm32(int rho) { const int n = rho >> 4, i = rho & 15; return 8 * (i >> 2) + 4 * n + (i & 3); }

struct Unit { int pm, pn, pnl; };
struct Gemm { const bf16_t* A; const bf16_t* Bt; int K; const int* rows; };

struct StaticOrder {
    int nM, nN, nwg, G, c;
    __device__ void init(int nM_, int nN_, int G_, int c_) { nM = nM_; nN = nN_; nwg = nM * nN; G = G_; c = c_; }
    __device__ bool next(int i, Unit& u) const {
        const long L = (long)i * G + c; if (L >= nwg) return false;
        int wgid = (int)L; { const int q = nwg / NXCD, r = nwg % NXCD, xcd = wgid % NXCD, off = wgid / NXCD; wgid = (xcd < r ? xcd * (q + 1) : r * (q + 1) + (xcd - r) * q) + off; }
        const int nig = WGM * nN, gid = wgid / nig, fm = gid * WGM, gsz = (nM - fm) < WGM ? (nM - fm) : WGM;
        u.pm = fm + ((wgid % nig) % gsz); u.pn = (wgid % nig) / gsz; u.pnl = u.pn; return true;
    }
};
struct MoeOrder {
    int nN, total, G, c; const LAS int* pexp;
    __device__ void init(int NP, int nN_, int G_, int c_, const LAS int* pexp_) { nN = nN_; total = NP * nN_; G = G_; c = c_; pexp = pexp_; }
    __device__ bool next(int i, Unit& u) const {
        const int L = i * G + c; if (L >= total) return false;
        u.pm = L / nN; u.pnl = L - u.pm * nN; u.pn = pexp[u.pm] * nN + u.pnl; return true;
    }
};

template <class Epi, class Sched, bool GATHER>
__device__ __forceinline__ void gemm_phase(LAS unsigned char* lds, const Gemm g, const Sched& S, const Epi& E) {
    const int tid = threadIdx.x, wid = __builtin_amdgcn_readfirstlane(tid >> 6), lane = tid & 63, wr = wid >> 2, wc = wid & 3, fr = lane & 15, fq = lane >> 4;
    const int K = g.K, nt = K / BK;
    const size_t kstep = (size_t)(BK * 2);
    const size_t hstep = (size_t)HALF * K * 2;
    const size_t tstep = 2 * hstep;
    int sR[2], sC[2];
    unsigned voffB[2], voffA[2][2], voffAn[2][2];
#pragma unroll
    for (int i = 0; i < 2; ++i) { stage_rc(tid * 16 + i * 8192, sR[i], sC[i]); const int Rb = Epi::PERM ? ((sR[i] & ~31) + perm32(sR[i] & 31)) : sR[i];
        voffB[i] = (unsigned)(Rb * K + sC[i]) * 2u;
        voffA[0][i] = (unsigned)(sR[i] * K + sC[i]) * 2u; voffA[1][i] = voffA[0][i] + (unsigned)hstep; voffAn[0][i] = voffA[0][i]; voffAn[1][i] = voffA[1][i]; }
    const unsigned ldsw = (unsigned)wid * 1024u;
    const int aoff = lds_byte(wr * 64 + fr, fq * 8), boff = lds_byte(wc * 32 + fr, fq * 8);
#define PG8_SA(b, h) (((b) * 2 + (h)) * HTB)
#define PG8_SB(b, h) ((4 + (b) * 2 + (h)) * HTB)
#define PG8_STAGE(bufoff, gbase, voff) do { _Pragma("unroll") for (int _i = 0; _i < 2; ++_i) \
        __builtin_amdgcn_global_load_lds((const unsigned*)((const char*)(gbase) + (voff)[_i]), (LAS unsigned*)(lds + (bufoff) + ldsw + _i * 8192), 16, 0, 0); } while (0)
#define PG8_LDA(dst, b, h) do { _Pragma("unroll") for (int m = 0; m < 4; ++m) _Pragma("unroll") for (int k = 0; k < 2; ++k) dst[m][k] = *(const LAS bf16x8*)(lds + PG8_SA(b, h) + aoff + m * 2048 + k * 1024); } while (0)
#define PG8_LDB(dst, b, h) do { _Pragma("unroll") for (int n = 0; n < 2; ++n) _Pragma("unroll") for (int k = 0; k < 2; ++k) dst[n][k] = *(const LAS bf16x8*)(lds + PG8_SB(b, h) + boff + n * 2048 + k * 1024); } while (0)
#define PG8_MMA(ai, bj, At, Bt) do { __builtin_amdgcn_s_setprio(1); _Pragma("unroll") for (int m = 0; m < 4; ++m) _Pragma("unroll") for (int n = 0; n < 2; ++n) _Pragma("unroll") for (int k = 0; k < 2; ++k) \
        acc[ai][bj][m][n] = __builtin_amdgcn_mfma_f32_16x16x32_bf16(Bt[n][k], At[m][k], acc[ai][bj][m][n], 0, 0, 0); __builtin_amdgcn_s_setprio(0); } while (0)
#define PG8_WAIT_V(n) asm volatile("s_waitcnt vmcnt(" #n ")" ::: "memory")
#define PG8_WAIT_L(n) asm volatile("s_waitcnt lgkmcnt(" #n ")" ::: "memory")
#define PG8_BAR __builtin_amdgcn_s_barrier()
#define PG8_SCHED __builtin_amdgcn_sched_barrier(0)
#define PG8_GATHER(dst, u) do { _Pragma("unroll") for (int _h = 0; _h < 2; ++_h) _Pragma("unroll") for (int _i = 0; _i < 2; ++_i) { \
        const int _e = g.rows[(u).pm * BM + _h * HALF + sR[_i]]; const int _t = _e < 0 ? 0 : (_e >> 1); dst[_h][_i] = (unsigned)(_t * K + sC[_i]) * 2u; } } while (0)
    Unit cur, nxt; int ui = 0;
    if (!S.next(0, cur)) return;
    f32x4 acc[2][2][4][2];
#pragma unroll
    for (int a = 0; a < 2; ++a)
#pragma unroll
        for (int b = 0; b < 2; ++b)
#pragma unroll
            for (int m = 0; m < 4; ++m)
#pragma unroll
                for (int n = 0; n < 2; ++n) acc[a][b][m][n] = (f32x4){0.f, 0.f, 0.f, 0.f};
    bf16x8 At[4][2], B0[2][2], B1[2][2];
    if constexpr (GATHER) PG8_GATHER(voffA, cur);
    const char* cA = GATHER ? (const char*)g.A : (const char*)g.A + (size_t)cur.pm * tstep; const char* cB = (const char*)g.Bt + (size_t)cur.pn * tstep;
    PG8_STAGE(PG8_SB(0, 0), cB, voffB); PG8_STAGE(PG8_SB(0, 1), cB + hstep, voffB); PG8_STAGE(PG8_SA(0, 0), cA, voffA[0]); PG8_STAGE(PG8_SA(0, 1), cA, voffA[1]);
    if (wr == 1) PG8_BAR;
    PG8_WAIT_V(2); PG8_BAR;
    PG8_STAGE(PG8_SB(1, 0), cB + kstep, voffB); PG8_STAGE(PG8_SA(1, 0), cA + kstep, voffA[0]); PG8_STAGE(PG8_SB(1, 1), cB + hstep + kstep, voffB);
    PG8_WAIT_V(6); PG8_BAR;
    for (;;) {
        const bool has_next = S.next(ui + 1, nxt);
        const char* nA = GATHER ? cA : (has_next ? (const char*)g.A + (size_t)nxt.pm * tstep : cA); const char* nB = has_next ? (const char*)g.Bt + (size_t)nxt.pn * tstep : cB;
        if constexpr (GATHER) { if (has_next) PG8_GATHER(voffAn, nxt); else {
#pragma unroll
            for (int h = 0; h < 2; ++h)
#pragma unroll
                for (int i = 0; i < 2; ++i) voffAn[h][i] = voffA[h][i]; } }
        for (int t = 0; t < nt; t += 2) {
            const bool last = (t == nt - 2);
            const char* a1 = cA + (size_t)(t + 1) * kstep;
            const char* a2 = last ? nA : cA + (size_t)(t + 2) * kstep; const char* b2 = last ? nB : cB + (size_t)(t + 2) * kstep;
            const char* a3 = a2 + kstep; const char* b3 = b2 + kstep;
            unsigned vo2[2][2];
#pragma unroll
            for (int h = 0; h < 2; ++h)
#pragma unroll
                for (int i = 0; i < 2; ++i) vo2[h][i] = (GATHER && last) ? voffAn[h][i] : voffA[h][i];
            PG8_LDB(B0, 0, 0); PG8_LDB(B1, 0, 1); PG8_SCHED; PG8_LDA(At, 0, 0); PG8_STAGE(PG8_SA(1, 1), a1, voffA[1]);
            PG8_WAIT_V(8); PG8_WAIT_L(0); PG8_BAR; PG8_MMA(0, 0, At, B0); PG8_MMA(0, 1, At, B1); PG8_BAR; PG8_SCHED;
            PG8_LDA(At, 0, 1); PG8_STAGE(PG8_SB(0, 0), b2, voffB); PG8_STAGE(PG8_SB(0, 1), b2 + hstep, voffB); PG8_STAGE(PG8_SA(0, 0), a2, vo2[0]);
            PG8_WAIT_V(8); PG8_WAIT_L(0); PG8_BAR; PG8_MMA(1, 0, At, B0); PG8_MMA(1, 1, At, B1); PG8_BAR; PG8_SCHED;
            PG8_LDB(B0, 1, 0); PG8_LDB(B1, 1, 1); PG8_SCHED; PG8_LDA(At, 1, 0); PG8_STAGE(PG8_SA(0, 1), a2, vo2[1]);
            PG8_WAIT_V(8); PG8_WAIT_L(0); PG8_BAR; PG8_MMA(0, 0, At, B0); PG8_MMA(0, 1, At, B1); PG8_BAR; PG8_SCHED;
            PG8_LDA(At, 1, 1); PG8_STAGE(PG8_SB(1, 0), b3, voffB); PG8_STAGE(PG8_SB(1, 1), b3 + hstep, voffB); PG8_STAGE(PG8_SA(1, 0), a3, vo2[0]);
            PG8_WAIT_V(8); PG8_WAIT_L(0); PG8_BAR; PG8_MMA(1, 0, At, B0); PG8_MMA(1, 1, At, B1); PG8_BAR; PG8_SCHED;
        }
        if (wr == 0) PG8_BAR;
        E(acc, cur, wr, wc, fr, fq);
        if (!has_next) break;
#pragma unroll
        for (int a = 0; a < 2; ++a)
#pragma unroll
            for (int b = 0; b < 2; ++b)
#pragma unroll
                for (int m = 0; m < 4; ++m)
#pragma unroll
                    for (int n = 0; n < 2; ++n) acc[a][b][m][n] = (f32x4){0.f, 0.f, 0.f, 0.f};
        cur = nxt; cA = nA; cB = nB; ++ui;
        if constexpr (GATHER) {
#pragma unroll
            for (int h = 0; h < 2; ++h)
#pragma unroll
                for (int i = 0; i < 2; ++i) voffA[h][i] = voffAn[h][i]; }
        if (wr == 1) PG8_BAR;
    }
    PG8_WAIT_V(0);
    PG8_BAR;
#undef PG8_SA
#undef PG8_SB
#undef PG8_STAGE
#undef PG8_LDA
#undef PG8_LDB
#undef PG8_MMA
#undef PG8_WAIT_V
#undef PG8_WAIT_L
#undef PG8_BAR
#undef PG8_SCHED
#undef PG8_GATHER
}

struct EpiInProj {
    static constexpr bool PERM = true;
    bf16_t* P; const float* qg; const float* kg;
    __device__ __forceinline__ void operator()(const f32x4 (&acc)[2][2][4][2], const Unit& u, int wr, int wc, int fr, int fq) const {
        const int pn = u.pnl; const int row0 = u.pm * BM + wr * 64 + fr;
        if (pn < 3 || pn >= 7) {
            const int col0 = pn * 256 + wc * 32 + 8 * fq;
#pragma unroll
            for (int ai = 0; ai < 2; ++ai)
#pragma unroll
                for (int m = 0; m < 4; ++m) { bf16_t* rowp = P + (size_t)(row0 + ai * HALF + m * 16) * INC + col0;
#pragma unroll
                    for (int bj = 0; bj < 2; ++bj) { f32x4 v0 = acc[ai][bj][m][0], v1 = acc[ai][bj][m][1];
                        if (pn < 2) { f32x2 a = gelu_pk((f32x2){v0[0], v0[1]}), b = gelu_pk((f32x2){v0[2], v0[3]}), c = gelu_pk((f32x2){v1[0], v1[1]}), d = gelu_pk((f32x2){v1[2], v1[3]});
                            v0 = (f32x4){a.x, a.y, b.x, b.y}; v1 = (f32x4){c.x, c.y, d.x, d.y}; }
                        u32x4 w; w.x = cvt_pk_bf16(v0[0], v0[1]); w.y = cvt_pk_bf16(v0[2], v0[3]); w.z = cvt_pk_bf16(v1[0], v1[1]); w.w = cvt_pk_bf16(v1[2], v1[3]);
                        *(u32x4*)(rowp + bj * HALF) = w; } }
        } else {
            const bool isq = pn < 5; const float* g = isq ? qg : kg; const float sc = isq ? 0.125f : 1.0f;
            f32x4 gv[2][2];
#pragma unroll
            for (int bj = 0; bj < 2; ++bj)
#pragma unroll
                for (int n = 0; n < 2; ++n) gv[bj][n] = *(const f32x4*)(g + bj * 32 + 8 * fq + 4 * n) * sc;
            const int col0 = pn * 256 + wc * 64 + 8 * fq;
#pragma unroll
            for (int ai = 0; ai < 2; ++ai)
#pragma unroll
                for (int m = 0; m < 4; ++m) { float ss = 0.f;
#pragma unroll
                    for (int bj = 0; bj < 2; ++bj)
#pragma unroll
                        for (int n = 0; n < 2; ++n) { const f32x4 x = acc[ai][bj][m][n]; ss += (x[0] * x[0] + x[1] * x[1]) + (x[2] * x[2] + x[3] * x[3]); }
                    ss += __shfl_xor(ss, 16); ss += __shfl_xor(ss, 32);
                    const float rs = __builtin_amdgcn_rsqf(ss * (1.0f / 64.0f) + EPS);
                    bf16_t* rowp = P + (size_t)(row0 + ai * HALF + m * 16) * INC + col0;
#pragma unroll
                    for (int bj = 0; bj < 2; ++bj) { const f32x4 v0 = acc[ai][bj][m][0] * rs * gv[bj][0], v1 = acc[ai][bj][m][1] * rs * gv[bj][1];
                        u32x4 w; w.x = cvt_pk_bf16(v0[0], v0[1]); w.y = cvt_pk_bf16(v0[2], v0[3]); w.z = cvt_pk_bf16(v1[0], v1[1]); w.w = cvt_pk_bf16(v1[2], v1[3]);
                        *(u32x4*)(rowp + bj * 32) = w; } }
        }
    }
};
struct EpiSwiGLU {
    static constexpr bool PERM = true;
    bf16_t* H; int ldc;
    __device__ __forceinline__ void operator()(const f32x4 (&acc)[2][2][4][2], const Unit& u, int wr, int wc, int fr, int fq) const {
        const int row0 = u.pm * BM + wr * 64 + fr, col0 = u.pnl * 128 + wc * 32 + 8 * fq;
#pragma unroll
        for (int ai = 0; ai < 2; ++ai)
#pragma unroll
            for (int m = 0; m < 4; ++m) { const f32x4 g0 = acc[ai][0][m][0], g1 = acc[ai][0][m][1], u0 = acc[ai][1][m][0], u1 = acc[ai][1][m][1];
                u32x4 w; w.x = cvt_pk_bf16(silu_f(g0[0]) * u0[0], silu_f(g0[1]) * u0[1]); w.y = cvt_pk_bf16(silu_f(g0[2]) * u0[2], silu_f(g0[3]) * u0[3]);
                w.z = cvt_pk_bf16(silu_f(g1[0]) * u1[0], silu_f(g1[1]) * u1[1]); w.w = cvt_pk_bf16(silu_f(g1[2]) * u1[2], silu_f(g1[3]) * u1[3]);
                *(u32x4*)(H + (size_t)(row0 + ai * HALF + m * 16) * ldc + col0) = w; }
    }
};
struct EpiResGate {
    static constexpr bool PERM = false;
    const float* res_l; const float* res_c; float* out_l; float* out_c; const float* gate;
    __device__ __forceinline__ void operator()(const f32x4 (&acc)[2][2][4][2], const Unit& u, int wr, int wc, int fr, int fq) const {
        const bool lat = u.pm < NLAT / BM; const int cond = lat ? (u.pm >> 4) : 4;
        const float* res = lat ? res_l : res_c; float* out = lat ? out_l : out_c;
        const int rowl = (lat ? u.pm : u.pm - NLAT / BM) * BM + wr * 64 + fr, col0 = u.pnl * BM + wc * 32 + 4 * fq;
        f32x4 gv[2][2];
#pragma unroll
        for (int bj = 0; bj < 2; ++bj)
#pragma unroll
            for (int n = 0; n < 2; ++n) gv[bj][n] = *(const f32x4*)(gate + (size_t)cond * 6 * D + col0 + bj * HALF + n * 16);
#pragma unroll
        for (int ai = 0; ai < 2; ++ai)
#pragma unroll
            for (int m = 0; m < 4; ++m) { const size_t off = (size_t)(rowl + ai * HALF + m * 16) * D + col0;
#pragma unroll
                for (int bj = 0; bj < 2; ++bj)
#pragma unroll
                    for (int n = 0; n < 2; ++n) { const f32x4 bs = *(const f32x4*)(res + off + bj * HALF + n * 16); *(f32x4*)(out + off + bj * HALF + n * 16) = bs + gv[bj][n] * acc[ai][bj][m][n]; }
                if (m & 1) asm volatile("" ::: "memory"); }
    }
};
struct EpiMoeDown {
    static constexpr bool PERM = true;
    bf16_t* Y; const int* rows; const float* lgate;
    __device__ __forceinline__ void operator()(const f32x4 (&acc)[2][2][4][2], const Unit& u, int wr, int wc, int fr, int fq) const {
        const int prow0 = u.pm * BM + wr * 64 + fr, col0 = u.pnl * BM + wc * 32 + 8 * fq;
#pragma unroll
        for (int ai = 0; ai < 2; ++ai)
#pragma unroll
            for (int m = 0; m < 4; ++m) { const int prow = prow0 + ai * HALF + m * 16; const int ent = rows[prow];
                if (ent >= 0) { const float gt = lgate[prow]; bf16_t* dst = Y + ((size_t)(ent & 1) * NLAT + (size_t)(ent >> 1)) * D + col0;
#pragma unroll
                    for (int bj = 0; bj < 2; ++bj) { const f32x4 v0 = acc[ai][bj][m][0] * gt, v1 = acc[ai][bj][m][1] * gt;
                        u32x4 w; w.x = cvt_pk_bf16(v0[0], v0[1]); w.y = cvt_pk_bf16(v0[2], v0[3]); w.z = cvt_pk_bf16(v1[0], v1[1]); w.w = cvt_pk_bf16(v1[2], v1[3]);
                        *(u32x4*)(dst + bj * HALF) = w; } } }
    }
};
}

#define XB_TMO      128
#define XB_XCNT(j)  (256  + 64 * (j))
#define XB_XSUB(j)  (1280 + 64 * (j))
#define XB_XGEN(j)  (2304 + 64 * (j))
#define XB_TOP      3328
#define XB_TOPGEN   3392
#define XCD_BAR_WORDS 3456
#define XB_SPIN_CAP (1u << 18)
__device__ __forceinline__ unsigned xb_ld(unsigned* p)              { return __hip_atomic_load(p, __ATOMIC_RELAXED, __HIP_MEMORY_SCOPE_AGENT); }
__device__ __forceinline__ unsigned xb_add(unsigned* p, unsigned v) { return __hip_atomic_fetch_add(p, v, __ATOMIC_RELAXED, __HIP_MEMORY_SCOPE_AGENT); }
__device__ __forceinline__ unsigned xb_xcc_id() { return (unsigned)__builtin_amdgcn_s_getreg((3 << 11) | 20) & 0xFu; }
#define XB_SPIN(cond, bar) do { unsigned _sp = 0; while (cond) { __builtin_amdgcn_s_sleep(1); \
    if ((++_sp & 255u) == 0u) { if (xb_ld(&(bar)[XB_TMO])) break; if (_sp > XB_SPIN_CAP) { atomicAdd(&(bar)[XB_TMO], 1u); break; } } } } while (0)
struct XcdBarrier { unsigned* bar; unsigned x; volatile LAS unsigned* st; };
__device__ __forceinline__ XcdBarrier xcd_barrier_post(unsigned* bar, volatile LAS unsigned* st) {
    XcdBarrier b; b.bar = bar; b.x = xb_xcc_id(); b.st = st;
    if (threadIdx.x == 0) (void)xb_add(&bar[XB_XCNT(b.x)], 1u);
    return b;
}
__device__ __forceinline__ void xcd_barrier_complete(unsigned* bar, unsigned x, unsigned& nloc, unsigned& nx) {
    const unsigned G = gridDim.x * gridDim.y * gridDim.z;
    unsigned sum, cnt, mine, sp = 0u;
    for (;;) {
        sum = 0u; cnt = 0u; mine = 0u;
#pragma unroll
        for (unsigned j = 0; j < 16; ++j) { const unsigned c = xb_ld(&bar[XB_XCNT(j)]); sum += c; cnt += (c > 0u) ? 1u : 0u; mine = (j == x) ? c : mine; }
        if (sum == G) break;
        __builtin_amdgcn_s_sleep(1);
        if ((++sp & 255u) == 0u) { if (xb_ld(&bar[XB_TMO])) break; if (sp > XB_SPIN_CAP) { atomicAdd(&bar[XB_TMO], 1u); break; } }
    }
    nloc = mine > 0u ? mine : 1u; nx = cnt > 0u ? cnt : 1u;
}
__device__ __forceinline__ void xcd_barrier(const XcdBarrier& b) {
    asm volatile("s_waitcnt vmcnt(0)" ::: "memory");
    __syncthreads();
    if (threadIdx.x == 0) {
        unsigned* bar = b.bar;
        __builtin_amdgcn_s_waitcnt(0);
        unsigned nloc = b.st[0], nx = b.st[1];
        if (nloc == 0u) { xcd_barrier_complete(bar, b.x, nloc, nx); b.st[0] = nloc; b.st[1] = nx; }
        const unsigned old = xb_add(&bar[XB_XSUB(b.x)], 1u);
        const unsigned gen = old / nloc;
        if (old + 1u == (gen + 1u) * nloc) {
            __builtin_amdgcn_fence(__ATOMIC_RELEASE, "agent");
            asm volatile("s_waitcnt vmcnt(0)" ::: "memory");
            const unsigned og = xb_add(&bar[XB_TOP], 1u);
            const unsigned tg = og / nx;
            if (og + 1u == (tg + 1u) * nx) xb_add(&bar[XB_TOPGEN], 1u);
            else XB_SPIN(xb_ld(&bar[XB_TOPGEN]) == tg, bar);
            __builtin_amdgcn_fence(__ATOMIC_ACQUIRE, "agent");
            xb_add(&bar[XB_XGEN(b.x)], 1u);
            asm volatile("s_waitcnt vmcnt(0)" ::: "memory");
        } else {
            XB_SPIN(xb_ld(&bar[XB_XGEN(b.x)]) == gen, bar);
            __builtin_amdgcn_fence(__ATOMIC_ACQUIRE, "agent");
            asm volatile("s_waitcnt vmcnt(0)" ::: "memory");
        }
    }
    __syncthreads();
}

struct Args {
    const float* in[26]; float* out; unsigned char* ws;
    int ph_lo, ph_hi;
};
struct Ctx {
    LAS unsigned char* lds; int tid, lane, wave, G, wg;
    unsigned char* ws; const float* const* in; float* out;
};

__device__ __forceinline__ int dest_row(int kind, int n) {
    if (kind == 1) { if (n >= OFF_Q && n < OFF_VV) { const int t = n >> 8, w = n & 255, h = w >> 6, d = w & 63; return (t << 8) + ((d >> 5) << 7) + (h << 5) + (d & 31); } return n; }
    if (kind == 2) return ((n >> 7) << 8) + (n & 127);
    if (kind == 3) return ((n >> 7) << 8) + 128 + (n & 127);
    return n;
}
__device__ __forceinline__ void cvt_item(const float* W, int K, int N, bf16_t* WT, int kind, LAS float* scr, int item, int lane) {
    const int nkb = K / 32, nb = item / nkb, kb = item - nb * nkb, k0 = kb * 32, n0 = nb * 64;
    const float* src = W + (size_t)(k0 + (lane >> 4)) * N + n0 + (lane & 15) * 4;
    f32x4 v[8];
#pragma unroll
    for (int it = 0; it < 8; ++it) v[it] = *(const f32x4*)(src + (size_t)it * 4 * N);
#pragma unroll
    for (int it = 0; it < 8; ++it) { LAS float* d = scr + (it * 4 + (lane >> 4)) * 65 + (lane & 15) * 4; d[0] = v[it][0]; d[1] = v[it][1]; d[2] = v[it][2]; d[3] = v[it][3]; }
    asm volatile("s_waitcnt lgkmcnt(0)" ::: "memory");
    const int c = lane & 3;
#pragma unroll
    for (int it = 0; it < 4; ++it) { const int nl = it * 16 + (lane >> 2); const LAS float* s = scr + (8 * c) * 65 + nl;
        u32x4 o; o.x = cvt_pk_bf16(s[0], s[65]); o.y = cvt_pk_bf16(s[2 * 65], s[3 * 65]); o.z = cvt_pk_bf16(s[4 * 65], s[5 * 65]); o.w = cvt_pk_bf16(s[6 * 65], s[7 * 65]);
        *(u32x4*)(WT + (size_t)dest_row(kind, n0 + nl) * K + k0 + 8 * c) = o; }
    asm volatile("s_waitcnt lgkmcnt(0)" ::: "memory");
}
__device__ __forceinline__ void p0_prologue(Ctx& F) {
    unsigned char* ws = F.ws;
    {
        LAS float* sc = (LAS float*)F.lds;
        LAS float* red = (LAS float*)(F.lds + 5 * D * 4);
        const float* c = F.in[1]; const float* c_ctx = F.in[3]; const float* w_mod = F.in[4]; const float* b_mod = F.in[5]; float* mod = (float*)(ws + WS_MOD);
        if (F.wg < 192) {
            for (int i = F.tid; i < 5 * D; i += 512) { const int cd = i >> 10, k = i & 1023; const float v = cd < 4 ? c[cd * D + k] : c_ctx[k]; sc[i] = v * __builtin_amdgcn_rcpf(1.f + __expf(-v)); }
            __syncthreads();
            const int l = F.wg / 96, n0 = (F.wg % 96) * 64, kq = F.tid >> 4, c4 = (F.tid & 15) * 4;
            const float* w = w_mod + (size_t)l * D * 6 * D + n0 + c4;
            f32x4 a[5];
#pragma unroll
            for (int cd = 0; cd < 5; ++cd) a[cd] = (f32x4){0.f, 0.f, 0.f, 0.f};
#pragma unroll 4
            for (int i = 0; i < 32; ++i) { const int k = kq + 32 * i; const f32x4 wv = *(const f32x4*)(w + (size_t)k * 6 * D);
#pragma unroll
                for (int cd = 0; cd < 5; ++cd) a[cd] += wv * sc[cd * D + k]; }
#pragma unroll
            for (int cd = 0; cd < 5; ++cd) *(LAS f32x4*)(red + (kq * 5 + cd) * 64 + c4) = a[cd];
            __syncthreads();
            if (F.tid < 320) { const int cd = F.tid >> 6, n = F.tid & 63; float s = 0.f;
#pragma unroll 8
                for (int q = 0; q < 32; ++q) s += red[(q * 5 + cd) * 64 + n];
                mod[((size_t)l * 5 + cd) * 6 * D + n0 + n] = s + b_mod[l * 6 * D + n0 + n]; }
            __syncthreads();
        }
    }
    {
        const float* a_ws = F.in[12]; const float* wp = F.in[14]; bf16_t* awsb = (bf16_t*)(ws + WS_AWS); bf16_t* wpt = (bf16_t*)(ws + WS_WPOOL);
        const int gt = F.wg * 512 + F.tid, NT = F.G * 512;
        for (int i = gt; i < 2 * 4 * 128 * 128 / 2; i += NT) { const f32x2 v = *(const f32x2*)(a_ws + 2 * i); *(unsigned*)(awsb + 2 * i) = cvt_pk_bf16(v.x, v.y); }
        for (int i = gt; i < 2 * 4 * 64 * 64; i += NT) { const int d = i & 63, e = (i >> 6) & 63, lg = i >> 12; wpt[i] = (bf16_t)(cvt_pk_bf16(wp[((size_t)lg * 64 + d) * 64 + e], 0.f) & 0xffffu); }
    }
    {
        LAS float* scr = (LAS float*)(F.lds + F.wave * (32 * 65 * 4));
        const int gw = F.wg * NWAVES + F.wave, NGW = F.G * NWAVES;
        constexpr int I_IN = (D / 32) * (INC / 64), I_OUT = (D / 32) * (D / 64), I_FG = (D / 32) * (DFF / 64), I_FD = (DFF / 32) * (D / 64), I_MG = (D / 32) * (DFE / 64), I_MD = (DFE / 32) * (D / 64);
        constexpr int T0 = 2 * I_IN, T1 = T0 + 2 * I_OUT, T2 = T1 + 2 * I_FG, T3 = T2 + I_FD, T4 = T3 + 2 * NE * I_MG, T5 = T4 + NE * I_MD;
        for (int it = gw; it < T5; it += NGW) {
            if (it < T0) { const int l = it / I_IN; cvt_item(F.in[8] + (size_t)l * D * INC, D, INC, (bf16_t*)(ws + WS_WIN) + (size_t)l * INC * D, 1, scr, it - l * I_IN, F.lane); }
            else if (it < T1) { const int r = it - T0, l = r / I_OUT; cvt_item(F.in[9] + (size_t)l * D * D, D, D, (bf16_t*)(ws + WS_WOUT) + (size_t)l * D * D, 0, scr, r - l * I_OUT, F.lane); }
            else if (it < T2) { const int r = it - T1, w = r / I_FG; cvt_item(w ? F.in[20] : F.in[19], D, DFF, (bf16_t*)(ws + WS_WGU), 2 + w, scr, r - w * I_FG, F.lane); }
            else if (it < T3) { cvt_item(F.in[21], DFF, D, (bf16_t*)(ws + WS_WD), 0, scr, it - T2, F.lane); }
            else if (it < T4) { const int r = it - T3, m = r / I_MG, w = m / NE, e = m - w * NE;
                cvt_item((w ? F.in[24] : F.in[23]) + (size_t)e * D * DFE, D, DFE, (bf16_t*)(ws + WS_MGU) + (size_t)e * 2 * DFE * D, 2 + w, scr, r - m * I_MG, F.lane); }
            else { const int r = it - T4, e = r / I_MD; cvt_item(F.in[25] + (size_t)e * DFE * D, DFE, D, (bf16_t*)(ws + WS_MD) + (size_t)e * D * DFE, 0, scr, r - e * I_MD, F.lane); }
        }
    }
}

template <bool ROUTE>
__device__ __forceinline__ void norm_phase(Ctx& F, const float* xl, const float* xc, const float* g, const float* modl, int shi, int sci, bf16_t* Hb, int nrows, const float* wr) {
    const int rpw = (nrows + F.G - 1) / F.G;
    LAS int* lcnt = (LAS int*)F.lds;
    if (ROUTE) { if (F.tid < 8) lcnt[F.tid] = 0; __syncthreads(); }
    for (int i = F.wave; i < rpw; i += NWAVES) {
        const int row = F.wg * rpw + i; if (row >= nrows) break;
        const float* x = row < NLAT ? xl + (size_t)row * D : xc + (size_t)(row - NLAT) * D;
        const int cd = row < NLAT ? row / SEQ : 4;
        const float* sh = modl + ((size_t)cd * 6 + shi) * D; const float* sc = modl + ((size_t)cd * 6 + sci) * D;
        f32x4 v[4]; float s = 0.f;
#pragma unroll
        for (int j = 0; j < 4; ++j) { v[j] = *(const f32x4*)(x + 256 * j + 4 * F.lane); s += (v[j][0] * v[j][0] + v[j][1] * v[j][1]) + (v[j][2] * v[j][2] + v[j][3] * v[j][3]); }
        const float rs = __builtin_amdgcn_rsqf(wave_sum(s) * (1.0f / D) + EPS);
#pragma unroll
        for (int j = 0; j < 4; ++j) { const int c = 256 * j + 4 * F.lane; const f32x4 gg = *(const f32x4*)(g + c), s1 = *(const f32x4*)(sc + c), s0 = *(const f32x4*)(sh + c);
            v[j] = v[j] * rs * gg * (s1 + 1.0f) + s0;
            u32x2 w; w.x = cvt_pk_bf16(v[j][0], v[j][1]); w.y = cvt_pk_bf16(v[j][2], v[j][3]); *(u32x2*)(Hb + (size_t)row * D + c) = w; }
        if (ROUTE) {
            float a[8];
#pragma unroll
            for (int e = 0; e < 8; ++e) a[e] = 0.f;
#pragma unroll
            for (int j = 0; j < 4; ++j)
#pragma unroll
                for (int q = 0; q < 4; ++q) { const int k = 256 * j + 4 * F.lane + q; const f32x4 w0 = *(const f32x4*)(wr + k * 8), w1 = *(const f32x4*)(wr + k * 8 + 4); const float hv = v[j][q];
                    a[0] += hv * w0[0]; a[1] += hv * w0[1]; a[2] += hv * w0[2]; a[3] += hv * w0[3]; a[4] += hv * w1[0]; a[5] += hv * w1[1]; a[6] += hv * w1[2]; a[7] += hv * w1[3]; }
#pragma unroll
            for (int e = 0; e < 8; ++e) a[e] = wave_sum(a[e]);
            int i0 = 0; float v0 = a[0];
#pragma unroll
            for (int e = 1; e < 8; ++e) if (a[e] > v0) { v0 = a[e]; i0 = e; }
            int i1 = -1; float v1 = -3.0e38f;
#pragma unroll
            for (int e = 0; e < 8; ++e) if (e != i0 && a[e] > v1) { v1 = a[e]; i1 = e; }
            if (F.lane == 0) { const float p1 = __expf(v1 - v0); const float g0 = 1.f / (1.f + p1);
                int* e01 = (int*)(F.ws + WS_E01); float* g01 = (float*)(F.ws + WS_G01);
                e01[row * 2] = i0; e01[row * 2 + 1] = i1; g01[row * 2] = g0; g01[row * 2 + 1] = p1 * g0;
                __hip_atomic_fetch_add(lcnt + i0, 1, __ATOMIC_RELAXED, __HIP_MEMORY_SCOPE_WORKGROUP); __hip_atomic_fetch_add(lcnt + i1, 1, __ATOMIC_RELAXED, __HIP_MEMORY_SCOPE_WORKGROUP); }
        }
    }
    if (ROUTE) { __syncthreads(); if (F.tid < 8) ((int*)(F.ws + WS_CNTW))[F.wg * 8 + F.tid] = lcnt[F.tid]; __syncthreads(); }
}

__device__ __forceinline__ void lists_phase(Ctx& F) {
    LAS int* tab = (LAS int*)F.lds;
    LAS int* offw = tab + 256 * 8;
    LAS int* tot = offw + 8;
    LAS int* pb = tot + 8;
    const int* cntw = (const int*)(F.ws + WS_CNTW);
    for (int i = F.tid; i < F.G * 8; i += 512) tab[i] = cntw[i];
    __syncthreads();
    if (F.tid < 8) { int o = 0, t = 0; for (int w = 0; w < F.G; ++w) { const int c = tab[w * 8 + F.tid]; if (w < F.wg) o += c; t += c; } offw[F.tid] = o; tot[F.tid] = t; }
    __syncthreads();
    if (F.tid == 0) { int p = 0; for (int e = 0; e < 8; ++e) { pb[e] = p; p += (tot[e] + 255) >> 8; } pb[8] = p; }
    __syncthreads();
    int* list = (int*)(F.ws + WS_LIST); float* lgate = (float*)(F.ws + WS_LGATE); int* pexp = (int*)(F.ws + WS_PEXP);
    if (F.wave == 0) {
        const int tok = F.wg * 64 + F.lane; const int* e01 = (const int*)(F.ws + WS_E01); const float* g01 = (const float*)(F.ws + WS_G01);
        const int e0 = e01[tok * 2], e1 = e01[tok * 2 + 1]; const float g0 = g01[tok * 2], g1 = g01[tok * 2 + 1];
#pragma unroll
        for (int e = 0; e < 8; ++e) { const bool f = (e0 == e) || (e1 == e); const unsigned long long bal = __ballot(f);
            if (f) { const int rank = __popcll(bal & ((1ull << F.lane) - 1ull)); const int pos = pb[e] * 256 + offw[e] + rank; const int slot = (e0 == e) ? 0 : 1;
                list[pos] = tok * 2 + slot; lgate[pos] = slot ? g1 : g0; } }
    }
    if (F.wg == 0) {
        for (int e = 0; e < 8; ++e) { const int n = tot[e], base = pb[e] * 256, end = (pb[e + 1]) * 256; for (int i = base + n + F.tid; i < end; i += 512) { list[i] = -1; lgate[i] = 0.f; } }
        for (int p = F.tid; p < MAXP; p += 512) { int e = 0;
#pragma unroll
            for (int q = 1; q < 8; ++q) if (p >= pb[q]) e = q;
            pexp[p] = e; }
        if (F.tid == 0) pexp[MAXP] = pb[8];
    }
    __syncthreads();
}

__device__ __forceinline__ s16x4 vtr(const LAS unsigned char* p) { typedef short v4i16_t __attribute__((ext_vector_type(4))); return __builtin_bit_cast(s16x4, __builtin_amdgcn_ds_read_tr16_b64_v4i16((LAS v4i16_t*)p)); }
__device__ __forceinline__ bf16x8 pack8(const f32x4 a, const f32x4 b) {
    u32x4 w; w.x = cvt_pk_bf16(a[0], a[1]); w.y = cvt_pk_bf16(a[2], a[3]); w.z = cvt_pk_bf16(b[0], b[1]); w.w = cvt_pk_bf16(b[2], b[3]); return __builtin_bit_cast(bf16x8, w);
}
__device__ __forceinline__ bf16x8 cat4(const s16x4 a, const s16x4 b) { return (bf16x8){a[0], a[1], a[2], a[3], b[0], b[1], b[2], b[3]}; }

template <int NQB, bool LOCAL>
__device__ __forceinline__ void attn_unit(Ctx& F, const bf16_t* P, bf16_t* MIX, const float* rpbh, int b, int h, int qrow0, int r, int jlo, int jhi) {
    LAS unsigned char* lds = F.lds; const int tid = F.tid, lane = F.lane, fr = lane & 15, fq = lane >> 4;
    LAS float* btab = (LAS float*)(lds + 32768);
    if (LOCAL) { for (int i = tid; i < 15 * 64; i += 512) { const int idx = (i & 63) - 16; btab[i] = (idx >= 0 && idx <= 30) ? rpbh[(i >> 6) * 31 + idx] : 0.f; } }
    unsigned wmask = 0u;
    if (LOCAL) {
#pragma unroll
        for (int qb = 0; qb < NQB; ++qb) { const int cw = qb == 0 ? 0 : (qb == 1 ? 8 : (qb == 2 ? 24 : 32)); const int qc = 16 * qb + fr; int cs = qc - 8; cs = cs < 0 ? 0 : (cs > 48 ? 48 : cs);
#pragma unroll
            for (int kb = 0; kb < 2; ++kb)
#pragma unroll
                for (int q = 0; q < 4; ++q) { const int kc = cw + 16 * kb + 4 * fq + q; if (kc >= cs && kc < cs + 16) wmask |= 1u << (qb * 8 + kb * 4 + q); } }
    }
    bf16x8 qf[NQB][2];
#pragma unroll
    for (int qb = 0; qb < NQB; ++qb)
#pragma unroll
        for (int ks = 0; ks < 2; ++ks) qf[qb][ks] = *(const bf16x8*)(P + (size_t)(qrow0 + qb * 16 + fr) * INC + OFF_Q + h * 64 + 8 * fq + 32 * ks);
    f32x4 o[NQB][4]; float mrun[NQB], lrun[NQB];
#pragma unroll
    for (int qb = 0; qb < NQB; ++qb) { mrun[qb] = -1.0e30f; lrun[qb] = 0.f;
#pragma unroll
        for (int db = 0; db < 4; ++db) o[qb][db] = (f32x4){0.f, 0.f, 0.f, 0.f}; }
    const int trow = tid >> 3, pc = tid & 7, lcK = pc ^ (trow & 7), lcV = pc ^ (((trow >> 1) & 3) << 1);
    const int T = 4 + (LOCAL ? (jhi - jlo) : 0);
    u32x4 kreg, vreg;
    { const size_t tok = (size_t)NLAT + b * CTX + trow; kreg = *(const u32x4*)(P + tok * INC + OFF_K + h * 64 + lcK * 8); vreg = *(const u32x4*)(P + tok * INC + OFF_VV + h * 64 + lcV * 8); }
    const int kaddr0 = fr * 128 + (((fq) ^ (fr & 7)) * 16), kaddr1 = fr * 128 + (((fq + 4) ^ (fr & 7)) * 16);
    const int vq = (lane & 15) >> 2, vp = lane & 3, vrow = 4 * fq + vq, vsw = ((vrow & 7) >> 1) << 1;
    for (int t = 0; t < T; ++t) {
        LAS unsigned char* slot = lds + (t & 1) * 16384;
        *(LAS u32x4*)(slot + tid * 16) = kreg; *(LAS u32x4*)(slot + 8192 + tid * 16) = vreg;
        if (t + 1 < T) { const int tn = t + 1; const size_t tok = tn < 4 ? (size_t)NLAT + b * CTX + tn * 64 + trow : (size_t)b * SEQ + (jlo + tn - 4) * 64 + trow;
            kreg = *(const u32x4*)(P + tok * INC + OFF_K + h * 64 + lcK * 8); vreg = *(const u32x4*)(P + tok * INC + OFF_VV + h * 64 + lcV * 8); }
        __syncthreads();
        const LAS unsigned char* Ks = slot; const LAS unsigned char* Vs = slot + 8192;
        if (t < 4) {
#pragma unroll
            for (int qb = 0; qb < NQB; ++qb) {
                f32x4 s[4];
#pragma unroll
                for (int kb = 0; kb < 4; ++kb) { s[kb] = __builtin_amdgcn_mfma_f32_16x16x32_bf16(*(const LAS bf16x8*)(Ks + kb * 2048 + kaddr0), qf[qb][0], (f32x4){0.f, 0.f, 0.f, 0.f}, 0, 0, 0);
                    s[kb] = __builtin_amdgcn_mfma_f32_16x16x32_bf16(*(const LAS bf16x8*)(Ks + kb * 2048 + kaddr1), qf[qb][1], s[kb], 0, 0, 0); }
                float tm = -1.0e30f;
#pragma unroll
                for (int kb = 0; kb < 4; ++kb) tm = fmaxf(fmaxf(tm, fmaxf(s[kb][0], s[kb][1])), fmaxf(s[kb][2], s[kb][3]));
                tm = fmaxf(tm, __shfl_xor(tm, 16)); tm = fmaxf(tm, __shfl_xor(tm, 32));
                const float mn = fmaxf(mrun[qb], tm), al = __builtin_amdgcn_exp2f((mrun[qb] - mn) * L2E), mb = mn * L2E; mrun[qb] = mn;
                float ps = 0.f;
#pragma unroll
                for (int kb = 0; kb < 4; ++kb)
#pragma unroll
                    for (int q = 0; q < 4; ++q) { const float p = __builtin_amdgcn_exp2f(s[kb][q] * L2E - mb); s[kb][q] = p; ps += p; }
                lrun[qb] = lrun[qb] * al + ps;
                const bf16x8 p0 = pack8(s[0], s[1]), p1 = pack8(s[2], s[3]);
#pragma unroll
                for (int db = 0; db < 4; ++db) { const int ca = (((2 * db + (vp >> 1)) ^ vsw) * 16) + (vp & 1) * 8;
                    const bf16x8 vf0 = cat4(vtr(Vs + vrow * 128 + ca), vtr(Vs + (16 + vrow) * 128 + ca)), vf1 = cat4(vtr(Vs + (32 + vrow) * 128 + ca), vtr(Vs + (48 + vrow) * 128 + ca));
                    o[qb][db] = o[qb][db] * al;
                    o[qb][db] = __builtin_amdgcn_mfma_f32_16x16x32_bf16(vf0, p0, o[qb][db], 0, 0, 0);
                    o[qb][db] = __builtin_amdgcn_mfma_f32_16x16x32_bf16(vf1, p1, o[qb][db], 0, 0, 0); }
                __builtin_amdgcn_sched_barrier(0);
            }
        } else if (LOCAL) {
            const int j = jlo + t - 4; int rs = r - 4; rs = rs < 0 ? 0 : (rs > 56 ? 56 : rs);
            if (j >= rs && j < rs + 8) {
                const LAS float* brow = btab + (j - r + 7) * 64 + (4 * fq - fr);
#pragma unroll
                for (int qb = 0; qb < NQB; ++qb) {
                    const int cw = qb == 0 ? 0 : (qb == 1 ? 8 : (qb == 2 ? 24 : 32));
                    f32x4 s[2];
#pragma unroll
                    for (int kb = 0; kb < 2; ++kb) { const LAS unsigned char* kp = Ks + (cw + 16 * kb) * 128;
                        s[kb] = __builtin_amdgcn_mfma_f32_16x16x32_bf16(*(const LAS bf16x8*)(kp + kaddr0), qf[qb][0], (f32x4){0.f, 0.f, 0.f, 0.f}, 0, 0, 0);
                        s[kb] = __builtin_amdgcn_mfma_f32_16x16x32_bf16(*(const LAS bf16x8*)(kp + kaddr1), qf[qb][1], s[kb], 0, 0, 0); }
                    float tm = -1.0e30f;
#pragma unroll
                    for (int kb = 0; kb < 2; ++kb)
#pragma unroll
                        for (int q = 0; q < 4; ++q) { const bool inw = (wmask >> (qb * 8 + kb * 4 + q)) & 1u;
                            const float sv = inw ? s[kb][q] + brow[31 + cw + 16 * kb + q - 16 * qb] : -1.0e30f; s[kb][q] = sv; tm = fmaxf(tm, sv); }
                    tm = fmaxf(tm, __shfl_xor(tm, 16)); tm = fmaxf(tm, __shfl_xor(tm, 32));
                    const float mn = fmaxf(mrun[qb], tm), al = __builtin_amdgcn_exp2f((mrun[qb] - mn) * L2E), mb = mn * L2E; mrun[qb] = mn;
                    float ps = 0.f;
#pragma unroll
                    for (int kb = 0; kb < 2; ++kb)
#pragma unroll
                        for (int q = 0; q < 4; ++q) { const float p = __builtin_amdgcn_exp2f(s[kb][q] * L2E - mb); s[kb][q] = p; ps += p; }
                    lrun[qb] = lrun[qb] * al + ps;
                    const bf16x8 p0 = pack8(s[0], s[1]);
#pragma unroll
                    for (int db = 0; db < 4; ++db) { const int ca = (((2 * db + (vp >> 1)) ^ vsw) * 16) + (vp & 1) * 8;
                        const bf16x8 vfr = cat4(vtr(Vs + (cw + vrow) * 128 + ca), vtr(Vs + (cw + 16 + vrow) * 128 + ca));
                        o[qb][db] = o[qb][db] * al;
                        o[qb][db] = __builtin_amdgcn_mfma_f32_16x16x32_bf16(vfr, p0, o[qb][db], 0, 0, 0); }
                    __builtin_amdgcn_sched_barrier(0);
                }
            }
        }
    }
#pragma unroll
    for (int qb = 0; qb < NQB; ++qb) { float l = lrun[qb]; l += __shfl_xor(l, 16); l += __shfl_xor(l, 32); const float inv = 1.0f / l;
        bf16_t* dst = MIX + (size_t)(qrow0 + qb * 16 + fr) * D + 512 + h * 64 + 4 * fq;
#pragma unroll
        for (int db = 0; db < 4; ++db) { const f32x4 v = o[qb][db] * inv; u32x2 w; w.x = cvt_pk_bf16(v[0], v[1]); w.y = cvt_pk_bf16(v[2], v[3]); *(u32x2*)(dst + 16 * db) = w; } }
    __syncthreads();
}

__device__ __forceinline__ void chunk_unit(Ctx& F, const bf16_t* P, bf16_t* MIX, const bf16_t* awsb, const float* a_bs, const float* vn_g, const float* vn_b,
                                           const bf16_t* wpt, const float* b_scale, int c0, int s0, int n) {
    LAS unsigned char* lds = F.lds; const int tid = F.tid, lane = F.lane, fr = lane & 15, fq = lane >> 4, w = F.wave;
    constexpr int VP = 272;
    {
        const int pos = tid >> 2, qt = tid & 3; const bf16_t* src = P + (size_t)(c0 + pos) * INC + OFF_V + qt * 64;
        float x[64]; float s = 0.f;
#pragma unroll
        for (int i = 0; i < 8; ++i) { float f[8]; unpack8(*(const u32x4*)(src + 8 * i), f);
#pragma unroll
            for (int q = 0; q < 8; ++q) { x[8 * i + q] = f[q]; s += f[q]; } }
        s += __shfl_xor(s, 1); s += __shfl_xor(s, 2);
        const float mean = s * (1.0f / 256.0f); float ss = 0.f;
#pragma unroll
        for (int i = 0; i < 64; ++i) { x[i] -= mean; ss += x[i] * x[i]; }
        ss += __shfl_xor(ss, 1); ss += __shfl_xor(ss, 2);
        const float rstd = __builtin_amdgcn_rsqf(ss * (1.0f / 256.0f) + EPS);
#pragma unroll
        for (int i = 0; i < 64; ++i) { const int ch = qt * 64 + i; const float y = x[i] * rstd * vn_g[ch] + vn_b[ch];
            *(LAS bf16_t*)(lds + ch * VP + pos * 2) = (bf16_t)(cvt_pk_bf16(y, 0.f) & 0xffffu); }
    }
    __syncthreads();
    {
        const int g = w >> 1, ih = w & 1;
        bf16x8 af[4][4];
#pragma unroll
        for (int cb = 0; cb < 4; ++cb)
#pragma unroll
            for (int ks = 0; ks < 4; ++ks) af[cb][ks] = *(const LAS bf16x8*)(lds + (g * 64 + cb * 16 + fr) * VP + (8 * fq + 32 * ks) * 2);
#pragma unroll
        for (int ib = 0; ib < 4; ++ib) { const int i0 = ih * 64 + ib * 16;
            bf16x8 bw[4];
#pragma unroll
            for (int ks = 0; ks < 4; ++ks) bw[ks] = *(const bf16x8*)(awsb + ((size_t)(g * 128 + i0 + fr) * 128 + 8 * fq + 32 * ks));
            const float bsv = a_bs[g * 128 + i0 + fr];
#pragma unroll
            for (int cb = 0; cb < 4; ++cb) { f32x4 acc = (f32x4){0.f, 0.f, 0.f, 0.f};
#pragma unroll
                for (int ks = 0; ks < 4; ++ks) acc = __builtin_amdgcn_mfma_f32_16x16x32_bf16(af[cb][ks], bw[ks], acc, 0, 0, 0);
                const int ch = g * 64 + cb * 16 + 4 * fq; const size_t row = (size_t)(c0 + i0 + fr);
                const u32x2 uu = *(const u32x2*)(P + row * INC + OFF_U + ch);
                const float u0 = __uint_as_float(uu.x << 16), u1 = __uint_as_float(uu.x & 0xffff0000u), u2 = __uint_as_float(uu.y << 16), u3 = __uint_as_float(uu.y & 0xffff0000u);
                u32x2 o; o.x = cvt_pk_bf16(u0 * (acc[0] + bsv), u1 * (acc[1] + bsv)); o.y = cvt_pk_bf16(u2 * (acc[2] + bsv), u3 * (acc[3] + bsv));
                *(u32x2*)(MIX + row * D + ch) = o; } }
    }
    __syncthreads();
    constexpr int ZP = 528;
    for (int i = tid; i < 145 * 32; i += 512) { const int zr = i >> 5, ck = i & 31; const int row = c0 - 8 + zr;
        if (row >= s0 && row < s0 + n) *(LAS u32x4*)(lds + zr * ZP + ck * 16) = *(const u32x4*)(P + (size_t)row * INC + OFF_Z + ck * 8); }
    __syncthreads();
    {
        const int t = c0 + 16 * w + fr, pos = t - s0, zr0 = 16 * w + fr + 8;
#pragma unroll
        for (int g = 0; g < 4; ++g) { const int half = 1 << g;
            int lo = pos - half; lo = lo < 0 ? 0 : lo; int hi = pos + half; hi = hi > n ? n : hi; const float icnt = 1.0f / (float)(hi - lo);
            f32x4 acc[4];
#pragma unroll
            for (int eb = 0; eb < 4; ++eb) acc[eb] = (f32x4){0.f, 0.f, 0.f, 0.f};
#pragma unroll
            for (int ks = 0; ks < 2; ++ks) { const int ch0 = g * 64 + ks * 32 + 8 * fq; float sum[8];
#pragma unroll
                for (int q = 0; q < 8; ++q) sum[q] = 0.f;
#pragma unroll
                for (int dt = -half; dt < half; ++dt) { const int pp = pos + dt; const bool ok = pp >= 0 && pp < n; float f[8]; unpack8(*(const LAS u32x4*)(lds + (zr0 + dt) * ZP + ch0 * 2), f);
#pragma unroll
                    for (int q = 0; q < 8; ++q) sum[q] += ok ? f[q] : 0.f; }
                float zc[8]; unpack8(*(const LAS u32x4*)(lds + zr0 * ZP + ch0 * 2), zc);
                f32x4 ya, yb; ya[0] = sum[0] * icnt - zc[0]; ya[1] = sum[1] * icnt - zc[1]; ya[2] = sum[2] * icnt - zc[2]; ya[3] = sum[3] * icnt - zc[3];
                yb[0] = sum[4] * icnt - zc[4]; yb[1] = sum[5] * icnt - zc[5]; yb[2] = sum[6] * icnt - zc[6]; yb[3] = sum[7] * icnt - zc[7];
                const bf16x8 yf = pack8(ya, yb);
#pragma unroll
                for (int eb = 0; eb < 4; ++eb) { const bf16x8 wf = *(const bf16x8*)(wpt + ((size_t)(g * 64 + eb * 16 + fr) * 64 + ks * 32 + 8 * fq));
                    acc[eb] = __builtin_amdgcn_mfma_f32_16x16x32_bf16(wf, yf, acc[eb], 0, 0, 0); } }
#pragma unroll
            for (int eb = 0; eb < 4; ++eb) { const int e0 = g * 64 + eb * 16 + 4 * fq; const f32x4 sc = *(const f32x4*)(b_scale + e0); const f32x4 v = acc[eb] * sc;
                u32x2 o; o.x = cvt_pk_bf16(v[0], v[1]); o.y = cvt_pk_bf16(v[2], v[3]); *(u32x2*)(MIX + (size_t)t * D + 256 + e0) = o; } }
    }
    __syncthreads();
}

template <int L>
__device__ __forceinline__ void mixer_phase(Ctx& F) {
    const bf16_t* P = (const bf16_t*)(F.ws + WS_PROJ); bf16_t* MIX = (bf16_t*)(F.ws + WS_MIX);
#ifndef MIX_NO_ATTN
    for (int u = F.wg; u < 256; u += F.G) {
        const int b = u >> 6, h = (u >> 3) & 7, R0 = (u & 7) * 8, r = R0 + F.wave;
        int jlo = R0 - 4; jlo = jlo < 0 ? 0 : (jlo > 56 ? 56 : jlo); int jhi = R0 + 3; jhi = (jhi < 0 ? 0 : (jhi > 56 ? 56 : jhi)) + 8;
        attn_unit<4, true>(F, P, MIX, F.in[18] + ((size_t)L * NH + h) * 15 * 31, b, h, b * SEQ + r * 64, r, jlo, jhi);
    }
#endif
    const int nchunk = (L == DEPTH - 1 ? NLAT : R) / 128;
    const bf16_t* awsb = (const bf16_t*)(F.ws + WS_AWS) + (size_t)L * 4 * 128 * 128; const bf16_t* wpt = (const bf16_t*)(F.ws + WS_WPOOL) + (size_t)L * 4 * 64 * 64;
#ifndef MIX_NO_CHUNK
    for (int u = F.wg; u < nchunk; u += F.G) {
        const int c0 = u * 128; int s0, n; if (c0 < NLAT) { s0 = (c0 / SEQ) * SEQ; n = SEQ; } else { s0 = NLAT + ((c0 - NLAT) / CTX) * CTX; n = CTX; }
        chunk_unit(F, P, MIX, awsb, F.in[13] + L * 4 * 128, F.in[10] + L * 256, F.in[11] + L * 256, wpt, F.in[15] + L * 256, c0, s0, n);
    }
#endif
#ifndef MIX_NO_CATTN
    if (L != DEPTH - 1) {
        for (int u = F.wg - nchunk % F.G; u < 64; u += F.G) { if (u < 0) continue;
            const int b = u >> 4, h = (u >> 1) & 7, half = u & 1;
            attn_unit<1, false>(F, P, MIX, nullptr, b, h, NLAT + b * CTX + half * 128 + F.wave * 16, 0, 0, 0);
        }
    }
#endif
}

__device__ __forceinline__ void combine_phase(Ctx& F, const float* modl) {
    const bf16_t* Y = (const bf16_t*)(F.ws + WS_Y); float* out = F.out;
    const int gw = F.wg * NWAVES + F.wave, NGW = F.G * NWAVES;
    for (int row = gw; row < NLAT; row += NGW) { const int cd = row / SEQ; const float* ga = modl + ((size_t)cd * 6 + 5) * D;
#pragma unroll
        for (int j = 0; j < 2; ++j) { const int c = 512 * j + 8 * F.lane; float a[8], bb[8];
            unpack8(*(const u32x4*)(Y + (size_t)row * D + c), a); unpack8(*(const u32x4*)(Y + ((size_t)NLAT + row) * D + c), bb);
            const f32x4 g0 = *(const f32x4*)(ga + c), g1 = *(const f32x4*)(ga + c + 4); float* o = out + (size_t)row * D + c;
            f32x4 x0 = *(const f32x4*)o, x1 = *(const f32x4*)(o + 4);
            x0[0] += g0[0] * (a[0] + bb[0]); x0[1] += g0[1] * (a[1] + bb[1]); x0[2] += g0[2] * (a[2] + bb[2]); x0[3] += g0[3] * (a[3] + bb[3]);
            x1[0] += g1[0] * (a[4] + bb[4]); x1[1] += g1[1] * (a[5] + bb[5]); x1[2] += g1[2] * (a[6] + bb[6]); x1[3] += g1[3] * (a[7] + bb[7]);
            *(f32x4*)o = x0; *(f32x4*)(o + 4) = x1; } }
}

#ifndef MK_PER_PHASE
#define MK_PER_PHASE 0
#endif
constexpr int NPHASE = 17;
__global__ void __launch_bounds__(NWAVES * 64, 2) mk_fwd(Args args) {
    extern __shared__ __attribute__((aligned(16))) unsigned char lds_raw[];
    Ctx F; F.lds = (LAS unsigned char*)lds_raw; F.tid = threadIdx.x; F.lane = F.tid & 63; F.wave = __builtin_amdgcn_readfirstlane(F.tid >> 6); F.G = gridDim.x; F.wg = blockIdx.x;
    F.ws = args.ws; F.in = args.in; F.out = args.out;
    volatile LAS unsigned* MISC = (volatile LAS unsigned*)(F.lds + LDSCTL_OFF);
    for (int u = F.tid; u < 256; u += NWAVES * 64) MISC[u] = 0u;
    __syncthreads();
    XcdBarrier bar; bar.bar = (unsigned*)(args.ws + WS_CTL); bar.x = 0; bar.st = nullptr;
    if (!MK_PER_PHASE) bar = xcd_barrier_post((unsigned*)(args.ws + WS_CTL), MISC + 8);
    const int lo = args.ph_lo, hi = args.ph_hi;
#ifndef PHASE_MASK
#define PHASE_MASK 0x1ffff
#endif
#define IN(k) ((((PHASE_MASK) >> (k)) & 1) && lo <= (k) && (k) < hi)
#define SEAM(k) do { if (IN(k) && IN((k) + 1)) xcd_barrier(bar); } while (0)
    unsigned char* ws = args.ws;
    const float* mod = (const float*)(ws + WS_MOD);
    bf16_t* Hb = (bf16_t*)(ws + WS_HB); bf16_t* PROJ = (bf16_t*)(ws + WS_PROJ); bf16_t* MIX = (bf16_t*)(ws + WS_MIX);
    float* X1 = (float*)(ws + WS_X1); float* XC1 = (float*)(ws + WS_XC1); float* XMC = (float*)(ws + WS_XMC);
    LAS int* pexp_l = (LAS int*)(F.lds + LDSCTL_OFF + 256);

    if (IN(0)) p0_prologue(F);
    SEAM(0);
    {
        const float* modl = mod;
        if (IN(1)) norm_phase<false>(F, F.in[0], F.in[2], F.in[6], modl, 0, 1, Hb, R, nullptr);
        SEAM(1);
        if (IN(2)) { pg8::Gemm g{Hb, (const bf16_t*)(ws + WS_WIN), D, nullptr}; pg8::StaticOrder S; S.init(R / 256, INC / 256, F.G, F.wg);
            pg8::EpiInProj E{PROJ, F.in[16], F.in[17]}; pg8::gemm_phase<pg8::EpiInProj, pg8::StaticOrder, false>(F.lds, g, S, E); }
        SEAM(2);
        if (IN(3)) mixer_phase<0>(F);
        SEAM(3);
        if (IN(4)) { pg8::Gemm g{MIX, (const bf16_t*)(ws + WS_WOUT), D, nullptr}; pg8::StaticOrder S; S.init(R / 256, D / 256, F.G, F.wg);
            pg8::EpiResGate E{F.in[0], F.in[2], F.out, XMC, modl + 2 * D}; pg8::gemm_phase<pg8::EpiResGate, pg8::StaticOrder, false>(F.lds, g, S, E); }
        SEAM(4);
        if (IN(5)) norm_phase<false>(F, F.out, XMC, F.in[7], modl, 3, 4, Hb, R, nullptr);
        SEAM(5);
        if (IN(6)) { pg8::Gemm g{Hb, (const bf16_t*)(ws + WS_WGU), D, nullptr}; pg8::StaticOrder S; S.init(R / 256, 2 * DFF / 256, F.G, F.wg);
            pg8::EpiSwiGLU E{(bf16_t*)(ws + WS_HFF), DFF}; pg8::gemm_phase<pg8::EpiSwiGLU, pg8::StaticOrder, false>(F.lds, g, S, E); }
        SEAM(6);
        if (IN(7)) { pg8::Gemm g{(const bf16_t*)(ws + WS_HFF), (const bf16_t*)(ws + WS_WD), DFF, nullptr}; pg8::StaticOrder S; S.init(R / 256, D / 256, F.G, F.wg);
            pg8::EpiResGate E{F.out, XMC, X1, XC1, modl + 5 * D}; pg8::gemm_phase<pg8::EpiResGate, pg8::StaticOrder, false>(F.lds, g, S, E); }
        SEAM(7);
    }
    {
        const float* modl = mod + 5 * 6 * D;
        if (IN(8)) norm_phase<false>(F, X1, XC1, F.in[6] + D, modl, 0, 1, Hb, R, nullptr);
        SEAM(8);
        if (IN(9)) { pg8::Gemm g{Hb, (const bf16_t*)(ws + WS_WIN) + (size_t)INC * D, D, nullptr}; pg8::StaticOrder S; S.init(R / 256, INC / 256, F.G, F.wg);
            pg8::EpiInProj E{PROJ, F.in[16] + HD, F.in[17] + HD}; pg8::gemm_phase<pg8::EpiInProj, pg8::StaticOrder, false>(F.lds, g, S, E); }
        SEAM(9);
        if (IN(10)) mixer_phase<1>(F);
        SEAM(10);
        if (IN(11)) { pg8::Gemm g{MIX, (const bf16_t*)(ws + WS_WOUT) + (size_t)D * D, D, nullptr}; pg8::StaticOrder S; S.init(NLAT / 256, D / 256, F.G, F.wg);
            pg8::EpiResGate E{X1, nullptr, F.out, nullptr, modl + 2 * D}; pg8::gemm_phase<pg8::EpiResGate, pg8::StaticOrder, false>(F.lds, g, S, E); }
        SEAM(11);
        if (IN(12)) norm_phase<true>(F, F.out, nullptr, F.in[7] + D, modl, 3, 4, Hb, NLAT, F.in[22]);
        SEAM(12);
        if (IN(13)) lists_phase(F);
        SEAM(13);
        if (IN(14) || IN(15)) { const int* pexp = (const int*)(ws + WS_PEXP); for (int i = F.tid; i <= MAXP; i += 512) pexp_l[i] = pexp[i]; __syncthreads(); }
        if (IN(14)) { pg8::Gemm g{Hb, (const bf16_t*)(ws + WS_MGU), D, (const int*)(ws + WS_LIST)}; pg8::MoeOrder S; S.init(pexp_l[MAXP], 2 * DFE / 256, F.G, F.wg, pexp_l);
            pg8::EpiSwiGLU E{(bf16_t*)(ws + WS_HFM), DFE}; pg8::gemm_phase<pg8::EpiSwiGLU, pg8::MoeOrder, true>(F.lds, g, S, E); }
        SEAM(14);
        if (IN(15)) { pg8::Gemm g{(const bf16_t*)(ws + WS_HFM), (const bf16_t*)(ws + WS_MD), DFE, nullptr}; pg8::MoeOrder S; S.init(pexp_l[MAXP], D / 256, F.G, F.wg, pexp_l);
            pg8::EpiMoeDown E{(bf16_t*)(ws + WS_Y), (const int*)(ws + WS_LIST), (const float*)(ws + WS_LGATE)}; pg8::gemm_phase<pg8::EpiMoeDown, pg8::MoeOrder, false>(F.lds, g, S, E); }
        SEAM(15);
        if (IN(16)) combine_phase(F, modl);
    }
#undef IN
#undef SEAM
}

extern "C" void kernel_launch(void* const* d_in, const int* in_sizes, int n_in, void* d_out, int out_size, void* d_ws, size_t ws_size, hipStream_t stream) {
    static int grid = 0;
    if (grid == 0) {
        if (n_in != 26 || in_sizes[0] != NLAT * D || out_size != NLAT * D || ws_size < WS_END) { fprintf(stderr, "kernel_launch: unexpected shapes / workspace (n_in %d, ws %zu)\n", n_in, ws_size); grid = -1; return; }
        int dev = 0, cus = 0, per_cu = 0;
        if (hipGetDevice(&dev) != hipSuccess || hipDeviceGetAttribute(&cus, hipDeviceAttributeMultiprocessorCount, dev) != hipSuccess) { grid = -1; return; }
        if (hipFuncSetAttribute((const void*)mk_fwd, hipFuncAttributeMaxDynamicSharedMemorySize, LDS_BYTES) != hipSuccess) { fprintf(stderr, "kernel_launch: hipFuncSetAttribute failed\n"); grid = -1; return; }
        if (hipOccupancyMaxActiveBlocksPerMultiprocessor(&per_cu, (const void*)mk_fwd, NWAVES * 64, LDS_BYTES) != hipSuccess || per_cu < 1) { fprintf(stderr, "kernel_launch: occupancy query says %d\n", per_cu); }
        (void)hipGetLastError();
        grid = cus;
    }
    if (grid < 0) return;
    (void)hipMemsetAsync((char*)d_ws + WS_CTL, 0, CTL_ZERO_BYTES, stream);
    Args a{};
    for (int i = 0; i < 26; ++i) a.in[i] = (const float*)d_in[i];
    a.out = (float*)d_out; a.ws = (unsigned char*)d_ws;
#if MK_PER_PHASE
    for (int p = 0; p < NPHASE; ++p) { a.ph_lo = p; a.ph_hi = p + 1; hipLaunchKernelGGL(mk_fwd, dim3(grid), dim3(NWAVES * 64), LDS_BYTES, stream, a); }
#else
    a.ph_lo = 0; a.ph_hi = NPHASE;
    hipLaunchKernelGGL(mk_fwd, dim3(grid), dim3(NWAVES * 64), LDS_BYTES, stream, a);
#endif
}
```

```cpp
#include <hip/hip_runtime.h>
#include <cstdio>
#include <cstdint>

#define LAS __attribute__((address_space(3)))
#define GAS __attribute__((address_space(1)))
typedef unsigned short bf16_t;
typedef short bf16x8 __attribute__((ext_vector_type(8)));
typedef short s16x4 __attribute__((ext_vector_type(4)));
typedef float f32x4 __attribute__((ext_vector_type(4)));
typedef float f32x2 __attribute__((ext_vector_type(2)));
typedef unsigned u32x4 __attribute__((ext_vector_type(4)));
typedef unsigned u32x2 __attribute__((ext_vector_type(2)));
typedef GAS unsigned gu32;

constexpr int D = 1024, BATCH = 4, SEQ = 4096, CTX = 256, DEPTH = 2;
constexpr int NLAT = BATCH * SEQ, NCTX = BATCH * CTX, R = NLAT + NCTX;
constexpr int INC = 2304, HD = 64, NH = 8;
constexpr int OFF_U = 0, OFF_V = 256, OFF_Z = 512, OFF_Q = 768, OFF_K = 1280, OFF_VV = 1792;
constexpr int DFF = 2816, NE = 8, DFE = 3584;
constexpr int MAXP = 136;
constexpr float EPS = 1e-6f;
constexpr float L2E = 1.4426950408889634f;

constexpr size_t MiB = 1u << 20;
constexpr size_t WS_CTL = 0, CTL_ZERO_BYTES = 64 * 1024;
constexpr size_t WS_MOD = 1 * MiB;
constexpr size_t WS_E01 = 2 * MiB, WS_G01 = 2 * MiB + 256 * 1024, WS_CNTW = 2 * MiB + 512 * 1024;
constexpr size_t WS_LIST = 3 * MiB, WS_LGATE = 3 * MiB + 256 * 1024, WS_PEXP = 3 * MiB + 512 * 1024;
constexpr size_t WS_WPOOL = 4 * MiB, WS_AWS = 4 * MiB + 512 * 1024;
constexpr size_t WS_WIN = 6 * MiB, WS_WOUT = 15 * MiB, WS_WGU = 19 * MiB, WS_WD = 30 * MiB;
constexpr size_t WS_MGU = 36 * MiB, WS_MD = 92 * MiB;
constexpr size_t WS_H8 = 120 * MiB;
constexpr size_t WS_Y = 136 * MiB;
constexpr size_t WS_HB = 204 * MiB, WS_XMC = 238 * MiB, WS_XC1 = 242 * MiB, WS_X1 = 246 * MiB, WS_PROJ = 310 * MiB, WS_MIX = 387 * MiB;
constexpr size_t WS_HFF = 310 * MiB;
constexpr size_t WS_HFM = 246 * MiB;
constexpr size_t WS_END = 421 * MiB;
static_assert(WS_HFM + (size_t)MAXP * 256 * DFE <= WS_END && WS_MD + (size_t)NE * D * DFE <= WS_H8 && WS_MGU + (size_t)NE * 2 * DFE * D <= WS_MD, "ws map");
static_assert(WS_MIX + (size_t)R * D * 2 <= WS_END && WS_PROJ + (size_t)R * INC * 2 <= WS_MIX && WS_HFF + (size_t)R * DFF * 2 <= WS_END, "ws map");
constexpr int SC_WGU = 121, SC_WD = 120, SC_ACT = 125;
constexpr float F8_WGU = 64.f, F8_WD = 128.f, F8_ACT = 4.f;

constexpr int RING_BYTES = 131072;
constexpr int LDSCTL_OFF = RING_BYTES;
constexpr int LDS_BYTES = 147456;
constexpr int NWAVES = 8;

__device__ __forceinline__ float bf2f(unsigned short h) { return __uint_as_float((unsigned)h << 16); }
__device__ __forceinline__ unsigned cvt_pk_bf16(float lo, float hi) { unsigned r; asm volatile("v_cvt_pk_bf16_f32 %0, %1, %2" : "=v"(r) : "v"(lo), "v"(hi)); return r; }
__device__ __forceinline__ float silu_f(float x) { return x * __builtin_amdgcn_rcpf(1.f + __builtin_amdgcn_exp2f(-x * L2E)); }
__device__ __forceinline__ float wave_sum(float v) {
#pragma unroll
    for (int o = 1; o < 64; o <<= 1) v += __shfl_xor(v, o);
    return v;
}
__device__ __forceinline__ f32x2 gelu_pk(f32x2 v) {
    const f32x2 av = __builtin_elementwise_abs(v), d = av * 0.2316418882f + 1.0f;
    f32x2 t; t.x = __builtin_amdgcn_rcpf(d.x); t.y = __builtin_amdgcn_rcpf(d.y);
    f32x2 q = t * 0.5307027145f + (-0.7265760135f); q = q * t + 0.7107068705f; q = q * t + (-0.142248368f); q = q * t + 0.127414796f; q = q * t;
    const f32x2 s = (v * v) * (-0.72134752044f);
    f32x2 e; e.x = __builtin_amdgcn_exp2f(s.x); e.y = __builtin_amdgcn_exp2f(s.y);
    const f32x2 m = v * (q * e), r = v - m;
    f32x2 o; o.x = v.x < 0.f ? m.x : r.x; o.y = v.y < 0.f ? m.y : r.y; return o;
}
__device__ __forceinline__ void unpack8(const u32x4 w, float (&f)[8]) {
    f[0] = __uint_as_float(w.x << 16); f[1] = __uint_as_float(w.x & 0xffff0000u); f[2] = __uint_as_float(w.y << 16); f[3] = __uint_as_float(w.y & 0xffff0000u);
    f[4] = __uint_as_float(w.z << 16); f[5] = __uint_as_float(w.z & 0xffff0000u); f[6] = __uint_as_float(w.w << 16); f[7] = __uint_as_float(w.w & 0xffff0000u);
}

__device__ __forceinline__ unsigned pk4_f8(float a, float b, float c, float d) {
    a = __builtin_amdgcn_fmed3f(a, -448.f, 448.f); b = __builtin_amdgcn_fmed3f(b, -448.f, 448.f); c = __builtin_amdgcn_fmed3f(c, -448.f, 448.f); d = __builtin_amdgcn_fmed3f(d, -448.f, 448.f);
    int p = __builtin_amdgcn_cvt_pk_fp8_f32(a, b, 0, false); p = __builtin_amdgcn_cvt_pk_fp8_f32(c, d, p, true); return (unsigned)p; }
namespace pg8 {
constexpr int BM = 256, BK = 64, HALF = 128, HTB = HALF * BK * 2, STAGE_BYTES = 8 * HTB, NXCD = 8, WGM = 8;
__host__ __device__ __forceinline__ int lds_byte(int r, int c) { const int st = (r >> 4) * 2 + (c >> 5), rr = r & 15, cc = c & 31, ob = rr * 64 + cc * 2; return st * 1024 + (ob ^ (((ob >> 9) & 1) << 5)); }
__host__ __device__ __forceinline__ void stage_rc(int b, int& Rr, int& C) { const int st = b / 1024, sb = b % 1024, swz = sb ^ (((sb >> 9) & 1) << 5); Rr = (st >> 1) * 16 + swz / 64; C = (st & 1) * 32 + (swz % 64) / 2; }
__host__ __device__ __forceinline__ int perm32(int rho) { const int n = rho >> 4, i = rho & 15; return 8 * (i >> 2) + 4 * n + (i & 3); }

typedef int v8i_t __attribute__((ext_vector_type(8)));
__device__ __forceinline__ v8i_t cat16(const bf16x8 a, const bf16x8 b) { const u32x4 x = __builtin_bit_cast(u32x4, a), y = __builtin_bit_cast(u32x4, b); return (v8i_t){(int)x[0], (int)x[1], (int)x[2], (int)x[3], (int)y[0], (int)y[1], (int)y[2], (int)y[3]}; }
union Frag { bf16x8 q[2]; v8i_t w; };
struct Unit { int pm, pn, pnl; };
struct Gemm { const void* A; const void* Bt; int K; const int* rows; int sa, sb; };

struct StaticOrder {
    int nM, nN, nwg, G, c;
    __device__ void init(int nM_, int nN_, int G_, int c_) { nM = nM_; nN = nN_; nwg = nM * nN; G = G_; c = c_; }
    __device__ bool next(int i, Unit& u) const {
        const long L = (long)i * G + c; if (L >= nwg) return false;
        int wgid = (int)L; { const int q = nwg / NXCD, r = nwg % NXCD, xcd = wgid % NXCD, off = wgid / NXCD; wgid = (xcd < r ? xcd * (q + 1) : r * (q + 1) + (xcd - r) * q) + off; }
        const int nig = WGM * nN, gid = wgid / nig, fm = gid * WGM, gsz = (nM - fm) < WGM ? (nM - fm) : WGM;
        u.pm = fm + ((wgid % nig) % gsz); u.pn = (wgid % nig) / gsz; u.pnl = u.pn; return true;
    }
};
struct MoeOrder {
    int nN, total, G, c; const LAS int* pexp;
    __device__ void init(int NP, int nN_, int G_, int c_, const LAS int* pexp_) { nN = nN_; total = NP * nN_; G = G_; c = c_; pexp = pexp_; }
    __device__ bool next(int i, Unit& u) const {
        const int L = i * G + c; if (L >= total) return false;
        u.pm = L / nN; u.pnl = L - u.pm * nN; u.pn = pexp[u.pm] * nN + u.pnl; return true;
    }
};

template <class Epi, class Sched, bool GATHER, bool F8 = false>
__device__ __forceinline__ void gemm_phase(LAS unsigned char* lds, const Gemm g, const Sched& S, const Epi& E) {
    const int tid = threadIdx.x, wid = __builtin_amdgcn_readfirstlane(tid >> 6), lane = tid & 63, wr = wid >> 2, wc = wid & 3, fr = lane & 15, fq = lane >> 4;
    const int K = g.K, KB = F8 ? K : 2 * K, nt = KB / (BK * 2);
    const unsigned kstep = (unsigned)(BK * 2);
    const unsigned hstep = (unsigned)HALF * KB;
    const unsigned tstep = 2 * hstep;
    const __amdgpu_buffer_rsrc_t rsA = __builtin_amdgcn_make_buffer_rsrc((void*)g.A, 0, 0xffffffff, 0x00020000), rsB = __builtin_amdgcn_make_buffer_rsrc((void*)g.Bt, 0, 0xffffffff, 0x00020000);
    int sR[2], sC[2];
    unsigned voffB[2], voffA[2][2], voffAn[2][2];
#pragma unroll
    for (int i = 0; i < 2; ++i) { stage_rc(tid * 16 + i * 8192, sR[i], sC[i]); const int Rb = Epi::PERM ? ((sR[i] & ~31) + perm32(sR[i] & 31)) : sR[i];
        voffB[i] = (unsigned)(Rb * KB + sC[i] * 2);
        voffA[0][i] = (unsigned)(sR[i] * KB + sC[i] * 2); voffA[1][i] = voffA[0][i] + hstep; voffAn[0][i] = voffA[0][i]; voffAn[1][i] = voffA[1][i]; }
    const unsigned ldsw = (unsigned)wid * 1024u;
    const int aoff = lds_byte(wr * 64 + fr, fq * 8), boff = lds_byte(wc * 32 + fr, fq * 8);
#define PG8_SA(b, h) (((b) * 2 + (h)) * HTB)
#define PG8_SB(b, h) ((4 + (b) * 2 + (h)) * HTB)
#define PG8_STAGE(bufoff, rs, soff, voff) do { _Pragma("unroll") for (int _i = 0; _i < 2; ++_i) \
        __builtin_amdgcn_raw_ptr_buffer_load_lds(rs, (LAS void*)(lds + (bufoff) + ldsw + _i * 8192), 16, (voff)[_i], (soff), 0, 0); } while (0)
#define PG8_LDA(dst, b, h) do { _Pragma("unroll") for (int m = 0; m < 4; ++m) { if constexpr (F8) dst[m].w = cat16(*(const LAS bf16x8*)(lds + PG8_SA(b, h) + aoff + m * 2048), *(const LAS bf16x8*)(lds + PG8_SA(b, h) + aoff + m * 2048 + 1024)); \
        else { _Pragma("unroll") for (int k = 0; k < 2; ++k) dst[m].q[k] = *(const LAS bf16x8*)(lds + PG8_SA(b, h) + aoff + m * 2048 + k * 1024); } } } while (0)
#define PG8_LDB(dst, b, h) do { _Pragma("unroll") for (int n = 0; n < 2; ++n) { if constexpr (F8) dst[n].w = cat16(*(const LAS bf16x8*)(lds + PG8_SB(b, h) + boff + n * 2048), *(const LAS bf16x8*)(lds + PG8_SB(b, h) + boff + n * 2048 + 1024)); \
        else { _Pragma("unroll") for (int k = 0; k < 2; ++k) dst[n].q[k] = *(const LAS bf16x8*)(lds + PG8_SB(b, h) + boff + n * 2048 + k * 1024); } } } while (0)
#define PG8_MMA(ai, bj, At, Bt) do { __builtin_amdgcn_s_setprio(1); _Pragma("unroll") for (int m = 0; m < 4; ++m) _Pragma("unroll") for (int n = 0; n < 2; ++n) { \
        if constexpr (F8) { asm volatile("v_mfma_scale_f32_16x16x128_f8f6f4 %0, %1, %2, %0, %3, %4 op_sel_hi:[0,0,0]" : "+v"(acc[ai][bj][m][n]) : "v"(Bt[n].w), "v"(At[m].w), "v"(g.sa), "v"(g.sb)); } \
        else { _Pragma("unroll") for (int k = 0; k < 2; ++k) acc[ai][bj][m][n] = __builtin_amdgcn_mfma_f32_16x16x32_bf16(Bt[n].q[k], At[m].q[k], acc[ai][bj][m][n], 0, 0, 0); } } \
        __builtin_amdgcn_s_setprio(0); } while (0)
#define PG8_WAIT_V(n) asm volatile("s_waitcnt vmcnt(" #n ")" ::: "memory")
#define PG8_WAIT_L(n) asm volatile("s_waitcnt lgkmcnt(" #n ")" ::: "memory")
#define PG8_BAR __builtin_amdgcn_s_barrier()
#define PG8_SCHED __builtin_amdgcn_sched_barrier(0)
#define PG8_GATHER(dst, u) do { _Pragma("unroll") for (int _h = 0; _h < 2; ++_h) _Pragma("unroll") for (int _i = 0; _i < 2; ++_i) { \
        const int _e = g.rows[(u).pm * BM + _h * HALF + sR[_i]]; const int _t = _e < 0 ? 0 : (_e >> 1); dst[_h][_i] = (unsigned)(_t * KB + sC[_i] * 2); } } while (0)
    Unit cur, nxt; int ui = 0;
    if (!S.next(0, cur)) return;
    f32x4 acc[2][2][4][2];
#pragma unroll
    for (int a = 0; a < 2; ++a)
#pragma unroll
        for (int b = 0; b < 2; ++b)
#pragma unroll
            for (int m = 0; m < 4; ++m)
#pragma unroll
                for (int n = 0; n < 2; ++n) acc[a][b][m][n] = (f32x4){0.f, 0.f, 0.f, 0.f};
    Frag At[4], B0[2], B1[2];
    if constexpr (GATHER) PG8_GATHER(voffA, cur);
    unsigned cA = GATHER ? 0u : (unsigned)cur.pm * tstep, cB = (unsigned)cur.pn * tstep;
    PG8_STAGE(PG8_SB(0, 0), rsB, cB, voffB); PG8_STAGE(PG8_SB(0, 1), rsB, cB + hstep, voffB); PG8_STAGE(PG8_SA(0, 0), rsA, cA, voffA[0]); PG8_STAGE(PG8_SA(0, 1), rsA, cA, voffA[1]);
    if (wr == 1) PG8_BAR;
    PG8_WAIT_V(2); PG8_BAR;
    PG8_STAGE(PG8_SB(1, 0), rsB, cB + kstep, voffB); PG8_STAGE(PG8_SA(1, 0), rsA, cA + kstep, voffA[0]); PG8_STAGE(PG8_SB(1, 1), rsB, cB + hstep + kstep, voffB);
    PG8_WAIT_V(6); PG8_BAR;
    for (;;) {
        const bool has_next = S.next(ui + 1, nxt);
        const unsigned nA = GATHER ? 0u : (has_next ? (unsigned)nxt.pm * tstep : cA), nB = has_next ? (unsigned)nxt.pn * tstep : cB;
        if constexpr (GATHER) { if (has_next) PG8_GATHER(voffAn, nxt); else {
#pragma unroll
            for (int h = 0; h < 2; ++h)
#pragma unroll
                for (int i = 0; i < 2; ++i) voffAn[h][i] = voffA[h][i]; } }
#pragma unroll 1
        for (int t = 0; t < nt; t += 2) {
            const bool last = (t == nt - 2);
            const unsigned a1 = cA + (unsigned)(t + 1) * kstep;
            const unsigned a2 = last ? nA : cA + (unsigned)(t + 2) * kstep, b2 = last ? nB : cB + (unsigned)(t + 2) * kstep;
            const unsigned a3 = a2 + kstep, b3 = b2 + kstep;
            unsigned vo2[2][2];
#pragma unroll
            for (int h = 0; h < 2; ++h)
#pragma unroll
                for (int i = 0; i < 2; ++i) vo2[h][i] = (GATHER && last) ? voffAn[h][i] : voffA[h][i];
            PG8_LDB(B0, 0, 0); PG8_LDB(B1, 0, 1); PG8_SCHED; PG8_LDA(At, 0, 0); PG8_STAGE(PG8_SA(1, 1), rsA, a1, voffA[1]);
            PG8_WAIT_V(8); PG8_WAIT_L(0); PG8_BAR; PG8_MMA(0, 0, At, B0); PG8_MMA(0, 1, At, B1); PG8_BAR; PG8_SCHED;
            PG8_LDA(At, 0, 1); PG8_STAGE(PG8_SB(0, 0), rsB, b2, voffB); PG8_STAGE(PG8_SB(0, 1), rsB, b2 + hstep, voffB); PG8_STAGE(PG8_SA(0, 0), rsA, a2, vo2[0]);
            PG8_WAIT_V(8); PG8_WAIT_L(0); PG8_BAR; PG8_MMA(1, 0, At, B0); PG8_MMA(1, 1, At, B1); PG8_BAR; PG8_SCHED;
            PG8_LDB(B0, 1, 0); PG8_LDB(B1, 1, 1); PG8_SCHED; PG8_LDA(At, 1, 0); PG8_STAGE(PG8_SA(0, 1), rsA, a2, vo2[1]);
            PG8_WAIT_V(8); PG8_WAIT_L(0); PG8_BAR; PG8_MMA(0, 0, At, B0); PG8_MMA(0, 1, At, B1); PG8_BAR; PG8_SCHED;
            PG8_LDA(At, 1, 1); PG8_STAGE(PG8_SB(1, 0), rsB, b3, voffB); PG8_STAGE(PG8_SB(1, 1), rsB, b3 + hstep, voffB); PG8_STAGE(PG8_SA(1, 0), rsA, a3, vo2[0]);
            PG8_WAIT_V(8); PG8_WAIT_L(0); PG8_BAR; PG8_MMA(1, 0, At, B0); PG8_MMA(1, 1, At, B1); PG8_BAR; PG8_SCHED;
        }
        if (wr == 0) PG8_BAR;
        if constexpr (F8) asm volatile("s_nop 15\n\ts_nop 15" ::: "memory");
        E(acc, cur, wr, wc, fr, fq);
        if (!has_next) break;
#pragma unroll
        for (int a = 0; a < 2; ++a)
#pragma unroll
            for (int b = 0; b < 2; ++b)
#pragma unroll
                for (int m = 0; m < 4; ++m)
#pragma unroll
                    for (int n = 0; n < 2; ++n) acc[a][b][m][n] = (f32x4){0.f, 0.f, 0.f, 0.f};
        cur = nxt; cA = nA; cB = nB; ++ui;
        if constexpr (GATHER) {
#pragma unroll
            for (int h = 0; h < 2; ++h)
#pragma unroll
                for (int i = 0; i < 2; ++i) voffA[h][i] = voffAn[h][i]; }
        if (wr == 1) PG8_BAR;
    }
    PG8_WAIT_V(0);
    PG8_BAR;
#undef PG8_SA
#undef PG8_SB
#undef PG8_STAGE
#undef PG8_LDA
#undef PG8_LDB
#undef PG8_MMA
#undef PG8_WAIT_V
#undef PG8_WAIT_L
#undef PG8_BAR
#undef PG8_SCHED
#undef PG8_GATHER
}

struct EpiInProj {
    static constexpr bool PERM = true;
    bf16_t* P; const float* qg; const float* kg;
    __device__ __forceinline__ void operator()(const f32x4 (&acc)[2][2][4][2], const Unit& u, int wr, int wc, int fr, int fq) const {
        const int pn = u.pnl; const int row0 = u.pm * BM + wr * 64 + fr;
        if (pn < 3 || pn >= 7) {
            const int col0 = pn * 256 + wc * 32 + 8 * fq;
#pragma unroll
            for (int ai = 0; ai < 2; ++ai)
#pragma unroll
                for (int m = 0; m < 4; ++m) { bf16_t* rowp = P + (size_t)(row0 + ai * HALF + m * 16) * INC + col0;
#pragma unroll
                    for (int bj = 0; bj < 2; ++bj) { f32x4 v0 = acc[ai][bj][m][0], v1 = acc[ai][bj][m][1];
                        if (pn < 2) { f32x2 a = gelu_pk((f32x2){v0[0], v0[1]}), b = gelu_pk((f32x2){v0[2], v0[3]}), c = gelu_pk((f32x2){v1[0], v1[1]}), d = gelu_pk((f32x2){v1[2], v1[3]});
                            v0 = (f32x4){a.x, a.y, b.x, b.y}; v1 = (f32x4){c.x, c.y, d.x, d.y}; }
                        u32x4 w; w.x = cvt_pk_bf16(v0[0], v0[1]); w.y = cvt_pk_bf16(v0[2], v0[3]); w.z = cvt_pk_bf16(v1[0], v1[1]); w.w = cvt_pk_bf16(v1[2], v1[3]);
                        *(u32x4*)(rowp + bj * HALF) = w; } }
        } else {
            const bool isq = pn < 5; const float* g = isq ? qg : kg; const float sc = isq ? 0.125f : 1.0f;
            f32x4 gv[2][2];
#pragma unroll
            for (int bj = 0; bj < 2; ++bj)
#pragma unroll
                for (int n = 0; n < 2; ++n) gv[bj][n] = *(const f32x4*)(g + bj * 32 + 8 * fq + 4 * n) * sc;
            const int col0 = pn * 256 + wc * 64 + 8 * fq;
#pragma unroll
            for (int ai = 0; ai < 2; ++ai)
#pragma unroll
                for (int m = 0; m < 4; ++m) { float ss = 0.f;
#pragma unroll
                    for (int bj = 0; bj < 2; ++bj)
#pragma unroll
                        for (int n = 0; n < 2; ++n) { const f32x4 x = acc[ai][bj][m][n]; ss += (x[0] * x[0] + x[1] * x[1]) + (x[2] * x[2] + x[3] * x[3]); }
                    ss += __shfl_xor(ss, 16); ss += __shfl_xor(ss, 32);
                    const float rs = __builtin_amdgcn_rsqf(ss * (1.0f / 64.0f) + EPS);
                    bf16_t* rowp = P + (size_t)(row0 + ai * HALF + m * 16) * INC + col0;
#pragma unroll
                    for (int bj = 0; bj < 2; ++bj) { const f32x4 v0 = acc[ai][bj][m][0] * rs * gv[bj][0], v1 = acc[ai][bj][m][1] * rs * gv[bj][1];
                        u32x4 w; w.x = cvt_pk_bf16(v0[0], v0[1]); w.y = cvt_pk_bf16(v0[2], v0[3]); w.z = cvt_pk_bf16(v1[0], v1[1]); w.w = cvt_pk_bf16(v1[2], v1[3]);
                        *(u32x4*)(rowp + bj * 32) = w; } }
        }
    }
};
template <bool OUT8> struct EpiSwiGLU {
    static constexpr bool PERM = true;
    void* H; int ldc;
    __device__ __forceinline__ void operator()(const f32x4 (&acc)[2][2][4][2], const Unit& u, int wr, int wc, int fr, int fq) const {
        const int row0 = u.pm * BM + wr * 64 + fr, col0 = u.pnl * 128 + wc * 32 + 8 * fq;
#pragma unroll
        for (int ai = 0; ai < 2; ++ai)
#pragma unroll
            for (int m = 0; m < 4; ++m) { const f32x4 g0 = acc[ai][0][m][0], g1 = acc[ai][0][m][1], u0 = acc[ai][1][m][0], u1 = acc[ai][1][m][1];
                const float h0 = silu_f(g0[0]) * u0[0], h1 = silu_f(g0[1]) * u0[1], h2 = silu_f(g0[2]) * u0[2], h3 = silu_f(g0[3]) * u0[3];
                const float h4 = silu_f(g1[0]) * u1[0], h5 = silu_f(g1[1]) * u1[1], h6 = silu_f(g1[2]) * u1[2], h7 = silu_f(g1[3]) * u1[3];
                const size_t off = (size_t)(row0 + ai * HALF + m * 16) * ldc + col0;
                if constexpr (OUT8) { u32x2 w; w.x = pk4_f8(h0 * F8_ACT, h1 * F8_ACT, h2 * F8_ACT, h3 * F8_ACT); w.y = pk4_f8(h4 * F8_ACT, h5 * F8_ACT, h6 * F8_ACT, h7 * F8_ACT); *(u32x2*)((unsigned char*)H + off) = w; }
                else { u32x4 w; w.x = cvt_pk_bf16(h0, h1); w.y = cvt_pk_bf16(h2, h3); w.z = cvt_pk_bf16(h4, h5); w.w = cvt_pk_bf16(h6, h7); *(u32x4*)((bf16_t*)H + off) = w; } }
    }
};
struct EpiResGate {
    static constexpr bool PERM = false;
    const float* res_l; const float* res_c; float* out_l; float* out_c; const float* gate;
    __device__ __forceinline__ void operator()(const f32x4 (&acc)[2][2][4][2], const Unit& u, int wr, int wc, int fr, int fq) const {
        const bool lat = u.pm < NLAT / BM; const int cond = lat ? (u.pm >> 4) : 4;
        const float* res = lat ? res_l : res_c; float* out = lat ? out_l : out_c;
        const int rowl = (lat ? u.pm : u.pm - NLAT / BM) * BM + wr * 64 + fr, col0 = u.pnl * BM + wc * 32 + 4 * fq;
        f32x4 gv[2][2];
#pragma unroll
        for (int bj = 0; bj < 2; ++bj)
#pragma unroll
            for (int n = 0; n < 2; ++n) gv[bj][n] = *(const f32x4*)(gate + (size_t)cond * 6 * D + col0 + bj * HALF + n * 16);
#pragma unroll
        for (int ai = 0; ai < 2; ++ai)
#pragma unroll
            for (int m = 0; m < 4; ++m) { const size_t off = (size_t)(rowl + ai * HALF + m * 16) * D + col0;
#pragma unroll
                for (int bj = 0; bj < 2; ++bj)
#pragma unroll
                    for (int n = 0; n < 2; ++n) { const f32x4 bs = *(const f32x4*)(res + off + bj * HALF + n * 16); *(f32x4*)(out + off + bj * HALF + n * 16) = bs + gv[bj][n] * acc[ai][bj][m][n]; }
                if (m & 1) asm volatile("" ::: "memory"); }
    }
};
struct EpiMoeDown {
    static constexpr bool PERM = true;
    bf16_t* Y; const int* rows; const float* lgate;
    __device__ __forceinline__ void operator()(const f32x4 (&acc)[2][2][4][2], const Unit& u, int wr, int wc, int fr, int fq) const {
        const int prow0 = u.pm * BM + wr * 64 + fr, col0 = u.pnl * BM + wc * 32 + 8 * fq;
#pragma unroll
        for (int ai = 0; ai < 2; ++ai)
#pragma unroll
            for (int m = 0; m < 4; ++m) { const int prow = prow0 + ai * HALF + m * 16; const int ent = rows[prow];
                if (ent >= 0) { const float gt = lgate[prow]; bf16_t* dst = Y + ((size_t)(ent & 1) * NLAT + (size_t)(ent >> 1)) * D + col0;
#pragma unroll
                    for (int bj = 0; bj < 2; ++bj) { const f32x4 v0 = acc[ai][bj][m][0] * gt, v1 = acc[ai][bj][m][1] * gt;
                        u32x4 w; w.x = cvt_pk_bf16(v0[0], v0[1]); w.y = cvt_pk_bf16(v0[2], v0[3]); w.z = cvt_pk_bf16(v1[0], v1[1]); w.w = cvt_pk_bf16(v1[2], v1[3]);
                        *(u32x4*)(dst + bj * HALF) = w; } } }
    }
};
}

#define XB_TMO      128
#define XB_XCNT(j)  (256  + 64 * (j))
#define XB_XSUB(j)  (1280 + 64 * (j))
#define XB_XGEN(j)  (2304 + 64 * (j))
#define XB_TOP      3328
#define XB_TOPGEN   3392
#define XCD_BAR_WORDS 3456
#define XB_SPIN_CAP (1u << 18)
__device__ __forceinline__ unsigned xb_ld(unsigned* p)              { return __hip_atomic_load(p, __ATOMIC_RELAXED, __HIP_MEMORY_SCOPE_AGENT); }
__device__ __forceinline__ unsigned xb_add(unsigned* p, unsigned v) { return __hip_atomic_fetch_add(p, v, __ATOMIC_RELAXED, __HIP_MEMORY_SCOPE_AGENT); }
__device__ __forceinline__ unsigned xb_xcc_id() { return (unsigned)__builtin_amdgcn_s_getreg((3 << 11) | 20) & 0xFu; }
#define XB_SPIN(cond, bar) do { unsigned _sp = 0; while (cond) { __builtin_amdgcn_s_sleep(1); \
    if ((++_sp & 255u) == 0u) { if (xb_ld(&(bar)[XB_TMO])) break; if (_sp > XB_SPIN_CAP) { atomicAdd(&(bar)[XB_TMO], 1u); break; } } } } while (0)
struct XcdBarrier { unsigned* bar; unsigned x; volatile LAS unsigned* st; };
__device__ __forceinline__ XcdBarrier xcd_barrier_post(unsigned* bar, volatile LAS unsigned* st) {
    XcdBarrier b; b.bar = bar; b.x = xb_xcc_id(); b.st = st;
    if (threadIdx.x == 0) (void)xb_add(&bar[XB_XCNT(b.x)], 1u);
    return b;
}
__device__ __forceinline__ void xcd_barrier_complete(unsigned* bar, unsigned x, unsigned& nloc, unsigned& nx) {
    const unsigned G = gridDim.x * gridDim.y * gridDim.z;
    unsigned sum, cnt, mine, sp = 0u;
    for (;;) {
        sum = 0u; cnt = 0u; mine = 0u;
#pragma unroll
        for (unsigned j = 0; j < 16; ++j) { const unsigned c = xb_ld(&bar[XB_XCNT(j)]); sum += c; cnt += (c > 0u) ? 1u : 0u; mine = (j == x) ? c : mine; }
        if (sum == G) break;
        __builtin_amdgcn_s_sleep(1);
        if ((++sp & 255u) == 0u) { if (xb_ld(&bar[XB_TMO])) break; if (sp > XB_SPIN_CAP) { atomicAdd(&bar[XB_TMO], 1u); break; } }
    }
    nloc = mine > 0u ? mine : 1u; nx = cnt > 0u ? cnt : 1u;
}
__device__ __forceinline__ void xcd_barrier(const XcdBarrier& b) {
    asm volatile("s_waitcnt vmcnt(0)" ::: "memory");
    __syncthreads();
    if (threadIdx.x == 0) {
        unsigned* bar = b.bar;
        __builtin_amdgcn_s_waitcnt(0);
        unsigned nloc = b.st[0], nx = b.st[1];
        if (nloc == 0u) { xcd_barrier_complete(bar, b.x, nloc, nx); b.st[0] = nloc; b.st[1] = nx; }
        const unsigned old = xb_add(&bar[XB_XSUB(b.x)], 1u);
        const unsigned gen = old / nloc;
        if (old + 1u == (gen + 1u) * nloc) {
            __builtin_amdgcn_fence(__ATOMIC_RELEASE, "agent");
            asm volatile("s_waitcnt vmcnt(0)" ::: "memory");
            const unsigned og = xb_add(&bar[XB_TOP], 1u);
            const unsigned tg = og / nx;
            if (og + 1u == (tg + 1u) * nx) xb_add(&bar[XB_TOPGEN], 1u);
            else XB_SPIN(xb_ld(&bar[XB_TOPGEN]) == tg, bar);
            __builtin_amdgcn_fence(__ATOMIC_ACQUIRE, "agent");
            xb_add(&bar[XB_XGEN(b.x)], 1u);
            asm volatile("s_waitcnt vmcnt(0)" ::: "memory");
        } else {
            XB_SPIN(xb_ld(&bar[XB_XGEN(b.x)]) == gen, bar);
            __builtin_amdgcn_fence(__ATOMIC_ACQUIRE, "agent");
            asm volatile("s_waitcnt vmcnt(0)" ::: "memory");
        }
    }
    __syncthreads();
}

struct Args {
    const float* in[26]; float* out; unsigned char* ws;
    int ph_lo, ph_hi;
};
struct Ctx {
    LAS unsigned char* lds; int tid, lane, wave, G, wg;
    unsigned char* ws; const float* const* in; float* out;
};

__device__ __forceinline__ int dest_row(int kind, int n) {
    if (kind == 1) { if (n >= OFF_Q && n < OFF_VV) { const int t = n >> 8, w = n & 255, h = w >> 6, d = w & 63; return (t << 8) + ((d >> 5) << 7) + (h << 5) + (d & 31); } return n; }
    if (kind == 2) return ((n >> 7) << 8) + (n & 127);
    if (kind == 3) return ((n >> 7) << 8) + 128 + (n & 127);
    return n;
}
__device__ __forceinline__ void cvt_item(const float* W, int K, int N, bf16_t* WT, int kind, LAS float* scr, int item, int lane) {
    const int nkb = K / 32, nb = item / nkb, kb = item - nb * nkb, k0 = kb * 32, n0 = nb * 64;
    const float* src = W + (size_t)(k0 + (lane >> 4)) * N + n0 + (lane & 15) * 4;
    f32x4 v[8];
#pragma unroll
    for (int it = 0; it < 8; ++it) v[it] = *(const f32x4*)(src + (size_t)it * 4 * N);
#pragma unroll
    for (int it = 0; it < 8; ++it) { LAS float* d = scr + (it * 4 + (lane >> 4)) * 65 + (lane & 15) * 4; d[0] = v[it][0]; d[1] = v[it][1]; d[2] = v[it][2]; d[3] = v[it][3]; }
    asm volatile("s_waitcnt lgkmcnt(0)" ::: "memory");
    const int c = lane & 3;
#pragma unroll
    for (int it = 0; it < 4; ++it) { const int nl = it * 16 + (lane >> 2); const LAS float* s = scr + (8 * c) * 65 + nl;
        u32x4 o; o.x = cvt_pk_bf16(s[0], s[65]); o.y = cvt_pk_bf16(s[2 * 65], s[3 * 65]); o.z = cvt_pk_bf16(s[4 * 65], s[5 * 65]); o.w = cvt_pk_bf16(s[6 * 65], s[7 * 65]);
        *(u32x4*)(WT + (size_t)dest_row(kind, n0 + nl) * K + k0 + 8 * c) = o; }
    asm volatile("s_waitcnt lgkmcnt(0)" ::: "memory");
}
__device__ __forceinline__ void cvt_item8(const float* W, int K, int N, unsigned char* WT, int kind, LAS float* scr, int item, int lane, float f8s) {
    const int nkb = K / 32, nb = item / nkb, kb = item - nb * nkb, k0 = kb * 32, n0 = nb * 64;
    const float* src = W + (size_t)(k0 + (lane >> 4)) * N + n0 + (lane & 15) * 4;
    f32x4 v[8];
#pragma unroll
    for (int it = 0; it < 8; ++it) v[it] = *(const f32x4*)(src + (size_t)it * 4 * N);
#pragma unroll
    for (int it = 0; it < 8; ++it) { LAS float* d = scr + (it * 4 + (lane >> 4)) * 65 + (lane & 15) * 4; d[0] = v[it][0]; d[1] = v[it][1]; d[2] = v[it][2]; d[3] = v[it][3]; }
    asm volatile("s_waitcnt lgkmcnt(0)" ::: "memory");
    const int c = lane & 3;
#pragma unroll
    for (int it = 0; it < 4; ++it) { const int nl = it * 16 + (lane >> 2); const LAS float* s = scr + (8 * c) * 65 + nl;
        u32x2 o; o.x = pk4_f8(s[0] * f8s, s[65] * f8s, s[2 * 65] * f8s, s[3 * 65] * f8s); o.y = pk4_f8(s[4 * 65] * f8s, s[5 * 65] * f8s, s[6 * 65] * f8s, s[7 * 65] * f8s);
        *(u32x2*)(WT + (size_t)dest_row(kind, n0 + nl) * K + k0 + 8 * c) = o; }
    asm volatile("s_waitcnt lgkmcnt(0)" ::: "memory");
}
__device__ __forceinline__ void p0_prologue(Ctx& F) {
    unsigned char* ws = F.ws;
    __syncthreads();
    {
        LAS float* sc = (LAS float*)F.lds;
        LAS float* red = (LAS float*)(F.lds + 5 * D * 4);
        const float* c = F.in[1]; const float* c_ctx = F.in[3]; const float* w_mod = F.in[4]; const float* b_mod = F.in[5]; float* mod = (float*)(ws + WS_MOD);
        if (F.wg < 192) {
            for (int i = F.tid; i < 5 * D; i += 512) { const int cd = i >> 10, k = i & 1023; const float v = cd < 4 ? c[cd * D + k] : c_ctx[k]; sc[i] = v * __builtin_amdgcn_rcpf(1.f + __expf(-v)); }
            __syncthreads();
            const int l = F.wg / 96, n0 = (F.wg % 96) * 64, kq = F.tid >> 4, c4 = (F.tid & 15) * 4;
            const float* w = w_mod + (size_t)l * D * 6 * D + n0 + c4;
            f32x4 a[5];
#pragma unroll
            for (int cd = 0; cd < 5; ++cd) a[cd] = (f32x4){0.f, 0.f, 0.f, 0.f};
#pragma unroll 4
            for (int i = 0; i < 32; ++i) { const int k = kq + 32 * i; const f32x4 wv = *(const f32x4*)(w + (size_t)k * 6 * D);
#pragma unroll
                for (int cd = 0; cd < 5; ++cd) a[cd] += wv * sc[cd * D + k]; }
#pragma unroll
            for (int cd = 0; cd < 5; ++cd) *(LAS f32x4*)(red + (kq * 5 + cd) * 64 + c4) = a[cd];
            __syncthreads();
            if (F.tid < 320) { const int cd = F.tid >> 6, n = F.tid & 63; float s = 0.f;
#pragma unroll 8
                for (int q = 0; q < 32; ++q) s += red[(q * 5 + cd) * 64 + n];
                mod[((size_t)l * 5 + cd) * 6 * D + n0 + n] = s + b_mod[l * 6 * D + n0 + n]; }
            __syncthreads();
        }
    }
    {
        const float* a_ws = F.in[12]; const float* wp = F.in[14]; bf16_t* awsb = (bf16_t*)(ws + WS_AWS); bf16_t* wpt = (bf16_t*)(ws + WS_WPOOL);
        const int gt = F.wg * 512 + F.tid, NT = F.G * 512;
        for (int i = gt; i < 2 * 4 * 128 * 128 / 2; i += NT) { const f32x2 v = *(const f32x2*)(a_ws + 2 * i); *(unsigned*)(awsb + 2 * i) = cvt_pk_bf16(v.x, v.y); }
        for (int i = gt; i < 2 * 4 * 64 * 64; i += NT) { const int d = i & 63, e = (i >> 6) & 63, lg = i >> 12; wpt[i] = (bf16_t)(cvt_pk_bf16(wp[((size_t)lg * 64 + d) * 64 + e], 0.f) & 0xffffu); }
    }
    {
        LAS float* scr = (LAS float*)(F.lds + F.wave * (32 * 65 * 4));
        const int gw = F.wg * NWAVES + F.wave, NGW = F.G * NWAVES;
        constexpr int I_IN = (D / 32) * (INC / 64), I_OUT = (D / 32) * (D / 64), I_FG = (D / 32) * (DFF / 64), I_FD = (DFF / 32) * (D / 64), I_MG = (D / 32) * (DFE / 64), I_MD = (DFE / 32) * (D / 64);
        constexpr int T0 = 2 * I_IN, T1 = T0 + 2 * I_OUT, T2 = T1 + 2 * I_FG, T3 = T2 + I_FD, T4 = T3 + 2 * NE * I_MG, T5 = T4 + NE * I_MD;
        for (int it = gw; it < T5; it += NGW) {
            if (it < T0) { const int l = it / I_IN; cvt_item(F.in[8] + (size_t)l * D * INC, D, INC, (bf16_t*)(ws + WS_WIN) + (size_t)l * INC * D, 1, scr, it - l * I_IN, F.lane); }
            else if (it < T1) { const int r = it - T0, l = r / I_OUT; cvt_item(F.in[9] + (size_t)l * D * D, D, D, (bf16_t*)(ws + WS_WOUT) + (size_t)l * D * D, 0, scr, r - l * I_OUT, F.lane); }
            else if (it < T2) { const int r = it - T1, w = r / I_FG; cvt_item(w ? F.in[20] : F.in[19], D, DFF, (bf16_t*)(ws + WS_WGU), 2 + w, scr, r - w * I_FG, F.lane); }
            else if (it < T3) { cvt_item(F.in[21], DFF, D, (bf16_t*)(ws + WS_WD), 0, scr, it - T2, F.lane); }
            else if (it < T4) { const int r = it - T3, m = r / I_MG, w = m / NE, e = m - w * NE;
                cvt_item8((w ? F.in[24] : F.in[23]) + (size_t)e * D * DFE, D, DFE, ws + WS_MGU + (size_t)e * 2 * DFE * D, 2 + w, scr, r - m * I_MG, F.lane, F8_WGU); }
            else { const int r = it - T4, e = r / I_MD; cvt_item8(F.in[25] + (size_t)e * DFE * D, DFE, D, ws + WS_MD + (size_t)e * D * DFE, 0, scr, r - e * I_MD, F.lane, F8_WD); }
        }
    }
}

template <bool ROUTE>
__device__ __forceinline__ void norm_phase(Ctx& F, const float* xl, const float* xc, const float* g, const float* modl, int shi, int sci, bf16_t* Hb, int nrows, const float* wr) {
    const int rpw = (nrows + F.G - 1) / F.G;
    LAS int* lcnt = (LAS int*)F.lds;
    if (ROUTE) { if (F.tid < 8) lcnt[F.tid] = 0; __syncthreads(); }
    for (int i = F.wave; i < rpw; i += NWAVES) {
        const int row = F.wg * rpw + i; if (row >= nrows) break;
        const float* x = row < NLAT ? xl + (size_t)row * D : xc + (size_t)(row - NLAT) * D;
        const int cd = row < NLAT ? row / SEQ : 4;
        const float* sh = modl + ((size_t)cd * 6 + shi) * D; const float* sc = modl + ((size_t)cd * 6 + sci) * D;
        f32x4 v[4]; float s = 0.f;
#pragma unroll
        for (int j = 0; j < 4; ++j) { v[j] = *(const f32x4*)(x + 256 * j + 4 * F.lane); s += (v[j][0] * v[j][0] + v[j][1] * v[j][1]) + (v[j][2] * v[j][2] + v[j][3] * v[j][3]); }
        const float rs = __builtin_amdgcn_rsqf(wave_sum(s) * (1.0f / D) + EPS);
#pragma unroll
        for (int j = 0; j < 4; ++j) { const int c = 256 * j + 4 * F.lane; const f32x4 gg = *(const f32x4*)(g + c), s1 = *(const f32x4*)(sc + c), s0 = *(const f32x4*)(sh + c);
            v[j] = v[j] * rs * gg * (s1 + 1.0f) + s0;
            if (ROUTE) *(unsigned*)((unsigned char*)Hb + (size_t)row * D + c) = pk4_f8(v[j][0] * F8_ACT, v[j][1] * F8_ACT, v[j][2] * F8_ACT, v[j][3] * F8_ACT);
            else { u32x2 w; w.x = cvt_pk_bf16(v[j][0], v[j][1]); w.y = cvt_pk_bf16(v[j][2], v[j][3]); *(u32x2*)(Hb + (size_t)row * D + c) = w; } }
        if (ROUTE) {
            float a[8];
#pragma unroll
            for (int e = 0; e < 8; ++e) a[e] = 0.f;
#pragma unroll
            for (int j = 0; j < 4; ++j)
#pragma unroll
                for (int q = 0; q < 4; ++q) { const int k = 256 * j + 4 * F.lane + q; const f32x4 w0 = *(const f32x4*)(wr + k * 8), w1 = *(const f32x4*)(wr + k * 8 + 4); const float hv = v[j][q];
                    a[0] += hv * w0[0]; a[1] += hv * w0[1]; a[2] += hv * w0[2]; a[3] += hv * w0[3]; a[4] += hv * w1[0]; a[5] += hv * w1[1]; a[6] += hv * w1[2]; a[7] += hv * w1[3]; }
#pragma unroll
            for (int e = 0; e < 8; ++e) a[e] = wave_sum(a[e]);
            int i0 = 0; float v0 = a[0];
#pragma unroll
            for (int e = 1; e < 8; ++e) if (a[e] > v0) { v0 = a[e]; i0 = e; }
            int i1 = -1; float v1 = -3.0e38f;
#pragma unroll
            for (int e = 0; e < 8; ++e) if (e != i0 && a[e] > v1) { v1 = a[e]; i1 = e; }
            if (F.lane == 0) { const float p1 = __expf(v1 - v0); const float g0 = 1.f / (1.f + p1);
                int* e01 = (int*)(F.ws + WS_E01); float* g01 = (float*)(F.ws + WS_G01);
                e01[row * 2] = i0; e01[row * 2 + 1] = i1; g01[row * 2] = g0; g01[row * 2 + 1] = p1 * g0;
                __hip_atomic_fetch_add(lcnt + i0, 1, __ATOMIC_RELAXED, __HIP_MEMORY_SCOPE_WORKGROUP); __hip_atomic_fetch_add(lcnt + i1, 1, __ATOMIC_RELAXED, __HIP_MEMORY_SCOPE_WORKGROUP); }
        }
    }
    if (ROUTE) { __syncthreads(); if (F.tid < 8) ((int*)(F.ws + WS_CNTW))[F.wg * 8 + F.tid] = lcnt[F.tid]; __syncthreads(); }
}

__device__ __forceinline__ void lists_phase(Ctx& F) {
    LAS int* tab = (LAS int*)F.lds;
    LAS int* offw = tab + 256 * 8;
    LAS int* tot = offw + 8;
    LAS int* pb = tot + 8;
    const int* cntw = (const int*)(F.ws + WS_CNTW);
    for (int i = F.tid; i < F.G * 8; i += 512) tab[i] = cntw[i];
    __syncthreads();
    if (F.tid < 8) { int o = 0, t = 0; for (int w = 0; w < F.G; ++w) { const int c = tab[w * 8 + F.tid]; if (w < F.wg) o += c; t += c; } offw[F.tid] = o; tot[F.tid] = t; }
    __syncthreads();
    if (F.tid == 0) { int p = 0; for (int e = 0; e < 8; ++e) { pb[e] = p; p += (tot[e] + 255) >> 8; } pb[8] = p; }
    __syncthreads();
    int* list = (int*)(F.ws + WS_LIST); float* lgate = (float*)(F.ws + WS_LGATE); int* pexp = (int*)(F.ws + WS_PEXP);
    if (F.wave == 0) {
        const int tok = F.wg * 64 + F.lane; const int* e01 = (const int*)(F.ws + WS_E01); const float* g01 = (const float*)(F.ws + WS_G01);
        const int e0 = e01[tok * 2], e1 = e01[tok * 2 + 1]; const float g0 = g01[tok * 2], g1 = g01[tok * 2 + 1];
#pragma unroll
        for (int e = 0; e < 8; ++e) { const bool f = (e0 == e) || (e1 == e); const unsigned long long bal = __ballot(f);
            if (f) { const int rank = __popcll(bal & ((1ull << F.lane) - 1ull)); const int pos = pb[e] * 256 + offw[e] + rank; const int slot = (e0 == e) ? 0 : 1;
                list[pos] = tok * 2 + slot; lgate[pos] = slot ? g1 : g0; } }
    }
    if (F.wg == 0) {
        for (int e = 0; e < 8; ++e) { const int n = tot[e], base = pb[e] * 256, end = (pb[e + 1]) * 256; for (int i = base + n + F.tid; i < end; i += 512) { list[i] = -1; lgate[i] = 0.f; } }
        for (int p = F.tid; p < MAXP; p += 512) { int e = 0;
#pragma unroll
            for (int q = 1; q < 8; ++q) if (p >= pb[q]) e = q;
            pexp[p] = e; }
        if (F.tid == 0) pexp[MAXP] = pb[8];
    }
    __syncthreads();
}

__device__ __forceinline__ s16x4 vtr(const LAS unsigned char* p) { typedef short v4i16_t __attribute__((ext_vector_type(4))); return __builtin_bit_cast(s16x4, __builtin_amdgcn_ds_read_tr16_b64_v4i16((LAS v4i16_t*)p)); }
__device__ __forceinline__ bf16x8 pack8(const f32x4 a, const f32x4 b) {
    u32x4 w; w.x = cvt_pk_bf16(a[0], a[1]); w.y = cvt_pk_bf16(a[2], a[3]); w.z = cvt_pk_bf16(b[0], b[1]); w.w = cvt_pk_bf16(b[2], b[3]); return __builtin_bit_cast(bf16x8, w);
}
__device__ __forceinline__ bf16x8 cat4(const s16x4 a, const s16x4 b) { return (bf16x8){a[0], a[1], a[2], a[3], b[0], b[1], b[2], b[3]}; }

template <int NQB, bool LOCAL>
__device__ __forceinline__ void attn_unit(Ctx& F, const bf16_t* P, bf16_t* MIX, const float* rpbh, int b, int h, int qrow0, int r, int jlo, int jhi) {
    LAS unsigned char* lds = F.lds; const int tid = F.tid, lane = F.lane, fr = lane & 15, fq = lane >> 4;
    LAS float* btab = (LAS float*)(lds + 32768);
    if (LOCAL) { for (int i = tid; i < 15 * 64; i += 512) { const int idx = (i & 63) - 16; btab[i] = (idx >= 0 && idx <= 30) ? rpbh[(i >> 6) * 31 + idx] : 0.f; } }
    unsigned wmask = 0u;
    if (LOCAL) {
#pragma unroll
        for (int qb = 0; qb < NQB; ++qb) { const int cw = qb == 0 ? 0 : (qb == 1 ? 8 : (qb == 2 ? 24 : 32)); const int qc = 16 * qb + fr; int cs = qc - 8; cs = cs < 0 ? 0 : (cs > 48 ? 48 : cs);
#pragma unroll
            for (int kb = 0; kb < 2; ++kb)
#pragma unroll
                for (int q = 0; q < 4; ++q) { const int kc = cw + 16 * kb + 4 * fq + q; if (kc >= cs && kc < cs + 16) wmask |= 1u << (qb * 8 + kb * 4 + q); } }
    }
    bf16x8 qf[NQB][2];
#pragma unroll
    for (int qb = 0; qb < NQB; ++qb)
#pragma unroll
        for (int ks = 0; ks < 2; ++ks) qf[qb][ks] = *(const bf16x8*)(P + (size_t)(qrow0 + qb * 16 + fr) * INC + OFF_Q + h * 64 + 8 * fq + 32 * ks);
    f32x4 o[NQB][4]; float mrun[NQB], lrun[NQB];
#pragma unroll
    for (int qb = 0; qb < NQB; ++qb) { mrun[qb] = -1.0e30f; lrun[qb] = 0.f;
#pragma unroll
        for (int db = 0; db < 4; ++db) o[qb][db] = (f32x4){0.f, 0.f, 0.f, 0.f}; }
    const int trow = tid >> 3, pc = tid & 7, lcK = pc ^ (trow & 7), lcV = pc ^ (((trow >> 1) & 3) << 1);
    const int T = 4 + (LOCAL ? (jhi - jlo) : 0);
    u32x4 kreg, vreg;
    { const size_t tok = (size_t)NLAT + b * CTX + trow; kreg = *(const u32x4*)(P + tok * INC + OFF_K + h * 64 + lcK * 8); vreg = *(const u32x4*)(P + tok * INC + OFF_VV + h * 64 + lcV * 8); }
    const int kaddr0 = fr * 128 + (((fq) ^ (fr & 7)) * 16), kaddr1 = fr * 128 + (((fq + 4) ^ (fr & 7)) * 16);
    const int vq = (lane & 15) >> 2, vp = lane & 3, vrow = 4 * fq + vq, vsw = ((vrow & 7) >> 1) << 1;
    for (int t = 0; t < T; ++t) {
        LAS unsigned char* slot = lds + (t & 1) * 16384;
        *(LAS u32x4*)(slot + tid * 16) = kreg; *(LAS u32x4*)(slot + 8192 + tid * 16) = vreg;
        if (t + 1 < T) { const int tn = t + 1; const size_t tok = tn < 4 ? (size_t)NLAT + b * CTX + tn * 64 + trow : (size_t)b * SEQ + (jlo + tn - 4) * 64 + trow;
            kreg = *(const u32x4*)(P + tok * INC + OFF_K + h * 64 + lcK * 8); vreg = *(const u32x4*)(P + tok * INC + OFF_VV + h * 64 + lcV * 8); }
        __syncthreads();
        const LAS unsigned char* Ks = slot; const LAS unsigned char* Vs = slot + 8192;
        if (t < 4) {
#pragma unroll
            for (int qb = 0; qb < NQB; ++qb) {
                f32x4 s[4];
#pragma unroll
                for (int kb = 0; kb < 4; ++kb) { s[kb] = __builtin_amdgcn_mfma_f32_16x16x32_bf16(*(const LAS bf16x8*)(Ks + kb * 2048 + kaddr0), qf[qb][0], (f32x4){0.f, 0.f, 0.f, 0.f}, 0, 0, 0);
                    s[kb] = __builtin_amdgcn_mfma_f32_16x16x32_bf16(*(const LAS bf16x8*)(Ks + kb * 2048 + kaddr1), qf[qb][1], s[kb], 0, 0, 0); }
                float tm = -1.0e30f;
#pragma unroll
                for (int kb = 0; kb < 4; ++kb) tm = fmaxf(fmaxf(tm, fmaxf(s[kb][0], s[kb][1])), fmaxf(s[kb][2], s[kb][3]));
                tm = fmaxf(tm, __shfl_xor(tm, 16)); tm = fmaxf(tm, __shfl_xor(tm, 32));
                const float mn = fmaxf(mrun[qb], tm), al = __builtin_amdgcn_exp2f((mrun[qb] - mn) * L2E), mb = mn * L2E; mrun[qb] = mn;
                float ps = 0.f;
#pragma unroll
                for (int kb = 0; kb < 4; ++kb)
#pragma unroll
                    for (int q = 0; q < 4; ++q) { const float p = __builtin_amdgcn_exp2f(s[kb][q] * L2E - mb); s[kb][q] = p; ps += p; }
                lrun[qb] = lrun[qb] * al + ps;
                const bf16x8 p0 = pack8(s[0], s[1]), p1 = pack8(s[2], s[3]);
#pragma unroll
                for (int db = 0; db < 4; ++db) { const int ca = (((2 * db + (vp >> 1)) ^ vsw) * 16) + (vp & 1) * 8;
                    const bf16x8 vf0 = cat4(vtr(Vs + vrow * 128 + ca), vtr(Vs + (16 + vrow) * 128 + ca)), vf1 = cat4(vtr(Vs + (32 + vrow) * 128 + ca), vtr(Vs + (48 + vrow) * 128 + ca));
                    o[qb][db] = o[qb][db] * al;
                    o[qb][db] = __builtin_amdgcn_mfma_f32_16x16x32_bf16(vf0, p0, o[qb][db], 0, 0, 0);
                    o[qb][db] = __builtin_amdgcn_mfma_f32_16x16x32_bf16(vf1, p1, o[qb][db], 0, 0, 0); }
                __builtin_amdgcn_sched_barrier(0);
            }
        } else if (LOCAL) {
            const int j = jlo + t - 4; int rs = r - 4; rs = rs < 0 ? 0 : (rs > 56 ? 56 : rs);
            if (j >= rs && j < rs + 8) {
                const LAS float* brow = btab + (j - r + 7) * 64 + (4 * fq - fr);
#pragma unroll
                for (int qb = 0; qb < NQB; ++qb) {
                    const int cw = qb == 0 ? 0 : (qb == 1 ? 8 : (qb == 2 ? 24 : 32));
                    f32x4 s[2];
#pragma unroll
                    for (int kb = 0; kb < 2; ++kb) { const LAS unsigned char* kp = Ks + (cw + 16 * kb) * 128;
                        s[kb] = __builtin_amdgcn_mfma_f32_16x16x32_bf16(*(const LAS bf16x8*)(kp + kaddr0), qf[qb][0], (f32x4){0.f, 0.f, 0.f, 0.f}, 0, 0, 0);
                        s[kb] = __builtin_amdgcn_mfma_f32_16x16x32_bf16(*(const LAS bf16x8*)(kp + kaddr1), qf[qb][1], s[kb], 0, 0, 0); }
                    float tm = -1.0e30f;
#pragma unroll
                    for (int kb = 0; kb < 2; ++kb)
#pragma unroll
                        for (int q = 0; q < 4; ++q) { const bool inw = (wmask >> (qb * 8 + kb * 4 + q)) & 1u;
                            const float sv = inw ? s[kb][q] + brow[31 + cw + 16 * kb + q - 16 * qb] : -1.0e30f; s[kb][q] = sv; tm = fmaxf(tm, sv); }
                    tm = fmaxf(tm, __shfl_xor(tm, 16)); tm = fmaxf(tm, __shfl_xor(tm, 32));
                    const float mn = fmaxf(mrun[qb], tm), al = __builtin_amdgcn_exp2f((mrun[qb] - mn) * L2E), mb = mn * L2E; mrun[qb] = mn;
                    float ps = 0.f;
#pragma unroll
                    for (int kb = 0; kb < 2; ++kb)
#pragma unroll
                        for (int q = 0; q < 4; ++q) { const float p = __builtin_amdgcn_exp2f(s[kb][q] * L2E - mb); s[kb][q] = p; ps += p; }
                    lrun[qb] = lrun[qb] * al + ps;
                    const bf16x8 p0 = pack8(s[0], s[1]);
#pragma unroll
                    for (int db = 0; db < 4; ++db) { const int ca = (((2 * db + (vp >> 1)) ^ vsw) * 16) + (vp & 1) * 8;
                        const bf16x8 vfr = cat4(vtr(Vs + (cw + vrow) * 128 + ca), vtr(Vs + (cw + 16 + vrow) * 128 + ca));
                        o[qb][db] = o[qb][db] * al;
                        o[qb][db] = __builtin_amdgcn_mfma_f32_16x16x32_bf16(vfr, p0, o[qb][db], 0, 0, 0); }
                    __builtin_amdgcn_sched_barrier(0);
                }
            }
        }
    }
#pragma unroll
    for (int qb = 0; qb < NQB; ++qb) { float l = lrun[qb]; l += __shfl_xor(l, 16); l += __shfl_xor(l, 32); const float inv = 1.0f / l;
        bf16_t* dst = MIX + (size_t)(qrow0 + qb * 16 + fr) * D + 512 + h * 64 + 4 * fq;
#pragma unroll
        for (int db = 0; db < 4; ++db) { const f32x4 v = o[qb][db] * inv; u32x2 w; w.x = cvt_pk_bf16(v[0], v[1]); w.y = cvt_pk_bf16(v[2], v[3]); *(u32x2*)(dst + 16 * db) = w; } }
    __syncthreads();
}

__device__ __forceinline__ void chunk_unit(Ctx& F, const bf16_t* P, bf16_t* MIX, const bf16_t* awsb, const float* a_bs, const float* vn_g, const float* vn_b,
                                           const bf16_t* wpt, const float* b_scale, int c0, int s0, int n) {
    LAS unsigned char* lds = F.lds; const int tid = F.tid, lane = F.lane, fr = lane & 15, fq = lane >> 4, w = F.wave;
    constexpr int VP = 272;
    {
        const int pos = tid >> 2, qt = tid & 3; const bf16_t* src = P + (size_t)(c0 + pos) * INC + OFF_V + qt * 64;
        float x[64]; float s = 0.f;
#pragma unroll
        for (int i = 0; i < 8; ++i) { float f[8]; unpack8(*(const u32x4*)(src + 8 * i), f);
#pragma unroll
            for (int q = 0; q < 8; ++q) { x[8 * i + q] = f[q]; s += f[q]; } }
        s += __shfl_xor(s, 1); s += __shfl_xor(s, 2);
        const float mean = s * (1.0f / 256.0f); float ss = 0.f;
#pragma unroll
        for (int i = 0; i < 64; ++i) { x[i] -= mean; ss += x[i] * x[i]; }
        ss += __shfl_xor(ss, 1); ss += __shfl_xor(ss, 2);
        const float rstd = __builtin_amdgcn_rsqf(ss * (1.0f / 256.0f) + EPS);
#pragma unroll
        for (int i = 0; i < 64; ++i) { const int ch = qt * 64 + i; const float y = x[i] * rstd * vn_g[ch] + vn_b[ch];
            *(LAS bf16_t*)(lds + ch * VP + pos * 2) = (bf16_t)(cvt_pk_bf16(y, 0.f) & 0xffffu); }
    }
    __syncthreads();
    {
        const int g = w >> 1, ih = w & 1;
        bf16x8 af[4][4];
#pragma unroll
        for (int cb = 0; cb < 4; ++cb)
#pragma unroll
            for (int ks = 0; ks < 4; ++ks) af[cb][ks] = *(const LAS bf16x8*)(lds + (g * 64 + cb * 16 + fr) * VP + (8 * fq + 32 * ks) * 2);
#pragma unroll
        for (int ib = 0; ib < 4; ++ib) { const int i0 = ih * 64 + ib * 16;
            bf16x8 bw[4];
#pragma unroll
            for (int ks = 0; ks < 4; ++ks) bw[ks] = *(const bf16x8*)(awsb + ((size_t)(g * 128 + i0 + fr) * 128 + 8 * fq + 32 * ks));
            const float bsv = a_bs[g * 128 + i0 + fr];
#pragma unroll
            for (int cb = 0; cb < 4; ++cb) { f32x4 acc = (f32x4){0.f, 0.f, 0.f, 0.f};
#pragma unroll
                for (int ks = 0; ks < 4; ++ks) acc = __builtin_amdgcn_mfma_f32_16x16x32_bf16(af[cb][ks], bw[ks], acc, 0, 0, 0);
                const int ch = g * 64 + cb * 16 + 4 * fq; const size_t row = (size_t)(c0 + i0 + fr);
                const u32x2 uu = *(const u32x2*)(P + row * INC + OFF_U + ch);
                const float u0 = __uint_as_float(uu.x << 16), u1 = __uint_as_float(uu.x & 0xffff0000u), u2 = __uint_as_float(uu.y << 16), u3 = __uint_as_float(uu.y & 0xffff0000u);
                u32x2 o; o.x = cvt_pk_bf16(u0 * (acc[0] + bsv), u1 * (acc[1] + bsv)); o.y = cvt_pk_bf16(u2 * (acc[2] + bsv), u3 * (acc[3] + bsv));
                *(u32x2*)(MIX + row * D + ch) = o; } }
    }
    __syncthreads();
    constexpr int ZP = 528;
    for (int i = tid; i < 145 * 32; i += 512) { const int zr = i >> 5, ck = i & 31; const int row = c0 - 8 + zr;
        if (row >= s0 && row < s0 + n) *(LAS u32x4*)(lds + zr * ZP + ck * 16) = *(const u32x4*)(P + (size_t)row * INC + OFF_Z + ck * 8); }
    __syncthreads();
    {
        const int t = c0 + 16 * w + fr, pos = t - s0, zr0 = 16 * w + fr + 8;
#pragma unroll
        for (int g = 0; g < 4; ++g) { const int half = 1 << g;
            int lo = pos - half; lo = lo < 0 ? 0 : lo; int hi = pos + half; hi = hi > n ? n : hi; const float icnt = 1.0f / (float)(hi - lo);
            f32x4 acc[4];
#pragma unroll
            for (int eb = 0; eb < 4; ++eb) acc[eb] = (f32x4){0.f, 0.f, 0.f, 0.f};
#pragma unroll
            for (int ks = 0; ks < 2; ++ks) { const int ch0 = g * 64 + ks * 32 + 8 * fq; float sum[8];
#pragma unroll
                for (int q = 0; q < 8; ++q) sum[q] = 0.f;
#pragma unroll
                for (int dt = -half; dt < half; ++dt) { const int pp = pos + dt; const bool ok = pp >= 0 && pp < n; float f[8]; unpack8(*(const LAS u32x4*)(lds + (zr0 + dt) * ZP + ch0 * 2), f);
#pragma unroll
                    for (int q = 0; q < 8; ++q) sum[q] += ok ? f[q] : 0.f; }
                float zc[8]; unpack8(*(const LAS u32x4*)(lds + zr0 * ZP + ch0 * 2), zc);
                f32x4 ya, yb; ya[0] = sum[0] * icnt - zc[0]; ya[1] = sum[1] * icnt - zc[1]; ya[2] = sum[2] * icnt - zc[2]; ya[3] = sum[3] * icnt - zc[3];
                yb[0] = sum[4] * icnt - zc[4]; yb[1] = sum[5] * icnt - zc[5]; yb[2] = sum[6] * icnt - zc[6]; yb[3] = sum[7] * icnt - zc[7];
                const bf16x8 yf = pack8(ya, yb);
#pragma unroll
                for (int eb = 0; eb < 4; ++eb) { const bf16x8 wf = *(const bf16x8*)(wpt + ((size_t)(g * 64 + eb * 16 + fr) * 64 + ks * 32 + 8 * fq));
                    acc[eb] = __builtin_amdgcn_mfma_f32_16x16x32_bf16(wf, yf, acc[eb], 0, 0, 0); } }
#pragma unroll
            for (int eb = 0; eb < 4; ++eb) { const int e0 = g * 64 + eb * 16 + 4 * fq; const f32x4 sc = *(const f32x4*)(b_scale + e0); const f32x4 v = acc[eb] * sc;
                u32x2 o; o.x = cvt_pk_bf16(v[0], v[1]); o.y = cvt_pk_bf16(v[2], v[3]); *(u32x2*)(MIX + (size_t)t * D + 256 + e0) = o; } }
    }
    __syncthreads();
}

template <int L>
__device__ __forceinline__ void mixer_phase(Ctx& F) {
    const bf16_t* P = (const bf16_t*)(F.ws + WS_PROJ); bf16_t* MIX = (bf16_t*)(F.ws + WS_MIX);
#ifndef MIX_NO_ATTN
#ifdef MIXDUP_ATTN
    for (int rep = 0; rep < 2; ++rep)
#endif
    for (int u = F.wg; u < 256; u += F.G) {
        const int b = u >> 6, h = (u >> 3) & 7, R0 = (u & 7) * 8, r = R0 + F.wave;
        int jlo = R0 - 4; jlo = jlo < 0 ? 0 : (jlo > 56 ? 56 : jlo); int jhi = R0 + 3; jhi = (jhi < 0 ? 0 : (jhi > 56 ? 56 : jhi)) + 8;
        attn_unit<4, true>(F, P, MIX, F.in[18] + ((size_t)L * NH + h) * 15 * 31, b, h, b * SEQ + r * 64, r, jlo, jhi);
    }
#endif
    const int nchunk = (L == DEPTH - 1 ? NLAT : R) / 128;
    const bf16_t* awsb = (const bf16_t*)(F.ws + WS_AWS) + (size_t)L * 4 * 128 * 128; const bf16_t* wpt = (const bf16_t*)(F.ws + WS_WPOOL) + (size_t)L * 4 * 64 * 64;
#ifndef MIX_NO_CHUNK
#ifdef MIXDUP_CHUNK
    for (int rep = 0; rep < 2; ++rep)
#endif
    for (int u = F.wg; u < nchunk; u += F.G) {
        const int c0 = u * 128; int s0, n; if (c0 < NLAT) { s0 = (c0 / SEQ) * SEQ; n = SEQ; } else { s0 = NLAT + ((c0 - NLAT) / CTX) * CTX; n = CTX; }
        chunk_unit(F, P, MIX, awsb, F.in[13] + L * 4 * 128, F.in[10] + L * 256, F.in[11] + L * 256, wpt, F.in[15] + L * 256, c0, s0, n);
    }
#endif
#ifndef MIX_NO_CATTN
    if (L != DEPTH - 1) {
        for (int u = F.wg - nchunk % F.G; u < 64; u += F.G) { if (u < 0) continue;
            const int b = u >> 4, h = (u >> 1) & 7, half = u & 1;
            attn_unit<1, false>(F, P, MIX, nullptr, b, h, NLAT + b * CTX + half * 128 + F.wave * 16, 0, 0, 0);
        }
    }
#endif
}

__device__ __forceinline__ void combine_phase(Ctx& F, const float* modl) {
    const bf16_t* Y = (const bf16_t*)(F.ws + WS_Y); float* out = F.out;
    const int gw = F.wg * NWAVES + F.wave, NGW = F.G * NWAVES;
    for (int row = gw; row < NLAT; row += NGW) { const int cd = row / SEQ; const float* ga = modl + ((size_t)cd * 6 + 5) * D;
#pragma unroll
        for (int j = 0; j < 2; ++j) { const int c = 512 * j + 8 * F.lane; float a[8], bb[8];
            unpack8(*(const u32x4*)(Y + (size_t)row * D + c), a); unpack8(*(const u32x4*)(Y + ((size_t)NLAT + row) * D + c), bb);
            const f32x4 g0 = *(const f32x4*)(ga + c), g1 = *(const f32x4*)(ga + c + 4); float* o = out + (size_t)row * D + c;
            f32x4 x0 = *(const f32x4*)o, x1 = *(const f32x4*)(o + 4);
            x0[0] += g0[0] * (a[0] + bb[0]); x0[1] += g0[1] * (a[1] + bb[1]); x0[2] += g0[2] * (a[2] + bb[2]); x0[3] += g0[3] * (a[3] + bb[3]);
            x1[0] += g1[0] * (a[4] + bb[4]); x1[1] += g1[1] * (a[5] + bb[5]); x1[2] += g1[2] * (a[6] + bb[6]); x1[3] += g1[3] * (a[7] + bb[7]);
            *(f32x4*)o = x0; *(f32x4*)(o + 4) = x1; } }
}

#ifndef MK_PER_PHASE
#define MK_PER_PHASE 0
#endif
constexpr int NPHASE = 17;
__global__ void __launch_bounds__(NWAVES * 64, 2) mk_fwd(Args args) {
    extern __shared__ __attribute__((aligned(16))) unsigned char lds_raw[];
    Ctx F; F.lds = (LAS unsigned char*)lds_raw; F.tid = threadIdx.x; F.lane = F.tid & 63; F.wave = __builtin_amdgcn_readfirstlane(F.tid >> 6); F.G = gridDim.x; F.wg = blockIdx.x;
    F.ws = args.ws; F.in = args.in; F.out = args.out;
    volatile LAS unsigned* MISC = (volatile LAS unsigned*)(F.lds + LDSCTL_OFF);
    for (int u = F.tid; u < 256; u += NWAVES * 64) MISC[u] = 0u;
    __syncthreads();
    XcdBarrier bar; bar.bar = (unsigned*)(args.ws + WS_CTL); bar.x = 0; bar.st = nullptr;
    if (!MK_PER_PHASE) bar = xcd_barrier_post((unsigned*)(args.ws + WS_CTL), MISC + 8);
    const int lo = args.ph_lo, hi = args.ph_hi;
#ifndef PHASE_MASK
#define PHASE_MASK 0x1ffff
#endif
#define IN(k) ((((PHASE_MASK) >> (k)) & 1) && lo <= (k) && (k) < hi)
#define SEAM(k) do { if (IN(k) && IN((k) + 1)) xcd_barrier(bar); } while (0)
#ifndef DUP_MASK
#define DUP_MASK 0
#endif
#define PHASE(k, ...) do { if (IN(k)) { __VA_ARGS__; if constexpr ((((DUP_MASK) >> (k)) & 1) != 0) { __VA_ARGS__; } } } while (0)
    unsigned char* ws = args.ws;
    const float* mod = (const float*)(ws + WS_MOD);
    bf16_t* Hb = (bf16_t*)(ws + WS_HB); bf16_t* PROJ = (bf16_t*)(ws + WS_PROJ); bf16_t* MIX = (bf16_t*)(ws + WS_MIX);
    float* X1 = (float*)(ws + WS_X1); float* XC1 = (float*)(ws + WS_XC1); float* XMC = (float*)(ws + WS_XMC);
    LAS int* pexp_l = (LAS int*)(F.lds + LDSCTL_OFF + 256);

    PHASE(0, p0_prologue(F));
    SEAM(0);
    {
        const float* modl = mod;
        PHASE(1, norm_phase<false>(F, F.in[0], F.in[2], F.in[6], modl, 0, 1, Hb, R, nullptr));
        SEAM(1);
        PHASE(2, { pg8::Gemm g{Hb, ws + WS_WIN, D, nullptr, 0, 0}; pg8::StaticOrder S; S.init(R / 256, INC / 256, F.G, F.wg); pg8::EpiInProj E{PROJ, F.in[16], F.in[17]}; pg8::gemm_phase<pg8::EpiInProj, pg8::StaticOrder, false>(F.lds, g, S, E); });
        SEAM(2);
        PHASE(3, mixer_phase<0>(F));
        SEAM(3);
        PHASE(4, { pg8::Gemm g{MIX, ws + WS_WOUT, D, nullptr, 0, 0}; pg8::StaticOrder S; S.init(R / 256, D / 256, F.G, F.wg); pg8::EpiResGate E{F.in[0], F.in[2], F.out, XMC, modl + 2 * D}; pg8::gemm_phase<pg8::EpiResGate, pg8::StaticOrder, false>(F.lds, g, S, E); });
        SEAM(4);
        PHASE(5, norm_phase<false>(F, F.out, XMC, F.in[7], modl, 3, 4, Hb, R, nullptr));
        SEAM(5);
        PHASE(6, { pg8::Gemm g{Hb, ws + WS_WGU, D, nullptr, 0, 0}; pg8::StaticOrder S; S.init(R / 256, 2 * DFF / 256, F.G, F.wg); pg8::EpiSwiGLU<false> E{ws + WS_HFF, DFF}; pg8::gemm_phase<pg8::EpiSwiGLU<false>, pg8::StaticOrder, false>(F.lds, g, S, E); });
        SEAM(6);
        PHASE(7, { pg8::Gemm g{ws + WS_HFF, ws + WS_WD, DFF, nullptr, 0, 0}; pg8::StaticOrder S; S.init(R / 256, D / 256, F.G, F.wg); pg8::EpiResGate E{F.out, XMC, X1, XC1, modl + 5 * D}; pg8::gemm_phase<pg8::EpiResGate, pg8::StaticOrder, false>(F.lds, g, S, E); });
        SEAM(7);
    }
    {
        const float* modl = mod + 5 * 6 * D;
        PHASE(8, norm_phase<false>(F, X1, XC1, F.in[6] + D, modl, 0, 1, Hb, R, nullptr));
        SEAM(8);
        PHASE(9, { pg8::Gemm g{Hb, ws + WS_WIN + (size_t)INC * D * 2, D, nullptr, 0, 0}; pg8::StaticOrder S; S.init(R / 256, INC / 256, F.G, F.wg); pg8::EpiInProj E{PROJ, F.in[16] + HD, F.in[17] + HD}; pg8::gemm_phase<pg8::EpiInProj, pg8::StaticOrder, false>(F.lds, g, S, E); });
        SEAM(9);
        PHASE(10, mixer_phase<1>(F));
        SEAM(10);
        PHASE(11, { pg8::Gemm g{MIX, ws + WS_WOUT + (size_t)D * D * 2, D, nullptr, 0, 0}; pg8::StaticOrder S; S.init(NLAT / 256, D / 256, F.G, F.wg); pg8::EpiResGate E{X1, nullptr, F.out, nullptr, modl + 2 * D}; pg8::gemm_phase<pg8::EpiResGate, pg8::StaticOrder, false>(F.lds, g, S, E); });
        SEAM(11);
        PHASE(12, norm_phase<true>(F, F.out, nullptr, F.in[7] + D, modl, 3, 4, (bf16_t*)(ws + WS_H8), NLAT, F.in[22]));
        SEAM(12);
        PHASE(13, lists_phase(F));
        SEAM(13);
        if (IN(14) || IN(15)) { const int* pexp = (const int*)(ws + WS_PEXP); for (int i = F.tid; i <= MAXP; i += 512) pexp_l[i] = pexp[i]; __syncthreads(); }
        PHASE(14, { pg8::Gemm g{ws + WS_H8, ws + WS_MGU, D, (const int*)(ws + WS_LIST), SC_WGU, SC_ACT}; pg8::MoeOrder S; S.init(pexp_l[MAXP], 2 * DFE / 256, F.G, F.wg, pexp_l); pg8::EpiSwiGLU<true> E{ws + WS_HFM, DFE}; pg8::gemm_phase<pg8::EpiSwiGLU<true>, pg8::MoeOrder, true, true>(F.lds, g, S, E); });
        SEAM(14);
        PHASE(15, { pg8::Gemm g{ws + WS_HFM, ws + WS_MD, DFE, nullptr, SC_WD, SC_ACT}; pg8::MoeOrder S; S.init(pexp_l[MAXP], D / 256, F.G, F.wg, pexp_l); pg8::EpiMoeDown E{(bf16_t*)(ws + WS_Y), (const int*)(ws + WS_LIST), (const float*)(ws + WS_LGATE)}; pg8::gemm_phase<pg8::EpiMoeDown, pg8::MoeOrder, false, true>(F.lds, g, S, E); });
        SEAM(15);
        if (IN(16)) combine_phase(F, modl);
    }
#undef IN
#undef SEAM
}

extern "C" void kernel_launch(void* const* d_in, const int* in_sizes, int n_in, void* d_out, int out_size, void* d_ws, size_t ws_size, hipStream_t stream) {
    static int grid = 0;
    if (grid == 0) {
        if (n_in != 26 || in_sizes[0] != NLAT * D || out_size != NLAT * D || ws_size < WS_END) { fprintf(stderr, "kernel_launch: unexpected shapes / workspace (n_in %d, ws %zu)\n", n_in, ws_size); grid = -1; return; }
        int dev = 0, cus = 0, per_cu = 0;
        if (hipGetDevice(&dev) != hipSuccess || hipDeviceGetAttribute(&cus, hipDeviceAttributeMultiprocessorCount, dev) != hipSuccess) { grid = -1; return; }
        if (hipFuncSetAttribute((const void*)mk_fwd, hipFuncAttributeMaxDynamicSharedMemorySize, LDS_BYTES) != hipSuccess) { fprintf(stderr, "kernel_launch: hipFuncSetAttribute failed\n"); grid = -1; return; }
        if (hipOccupancyMaxActiveBlocksPerMultiprocessor(&per_cu, (const void*)mk_fwd, NWAVES * 64, LDS_BYTES) != hipSuccess || per_cu < 1) { fprintf(stderr, "kernel_launch: occupancy query says %d\n", per_cu); }
        (void)hipGetLastError();
        grid = cus;
    }
    if (grid < 0) return;
    (void)hipMemsetAsync((char*)d_ws + WS_CTL, 0, CTL_ZERO_BYTES, stream);
    Args a{};
    for (int i = 0; i < 26; ++i) a.in[i] = (const float*)d_in[i];
    a.out = (float*)d_out; a.ws = (unsigned char*)d_ws;
#if MK_PER_PHASE
    for (int p = 0; p < NPHASE; ++p) { a.ph_lo = p; a.ph_hi = p + 1; hipLaunchKernelGGL(mk_fwd, dim3(grid), dim3(NWAVES * 64), LDS_BYTES, stream, a); }
#else
    a.ph_lo = 0; a.ph_hi = NPHASE;
    hipLaunchKernelGGL(mk_fwd, dim3(grid), dim3(NWAVES * 64), LDS_BYTES, stream, a);
#endif
}
```

```cpp
#include <hip/hip_runtime.h>
#include <cstdio>
#include <cstdint>

#define LAS __attribute__((address_space(3)))
#define GAS __attribute__((address_space(1)))
typedef unsigned short bf16_t;
typedef short bf16x8 __attribute__((ext_vector_type(8)));
typedef short s16x4 __attribute__((ext_vector_type(4)));
typedef float f32x4 __attribute__((ext_vector_type(4)));
typedef float f32x2 __attribute__((ext_vector_type(2)));
typedef unsigned u32x4 __attribute__((ext_vector_type(4)));
typedef unsigned u32x2 __attribute__((ext_vector_type(2)));
typedef GAS unsigned gu32;

constexpr int D = 1024, BATCH = 4, SEQ = 4096, CTX = 256, DEPTH = 2;
constexpr int NLAT = BATCH * SEQ, NCTX = BATCH * CTX, R = NLAT + NCTX;
constexpr int INC = 2304, HD = 64, NH = 8;
constexpr int OFF_U = 0, OFF_V = 256, OFF_Z = 512, OFF_Q = 768, OFF_K = 1280, OFF_VV = 1792;
constexpr int DFF = 2816, NE = 8, DFE = 3584;
constexpr int MAXP = 136;
constexpr float EPS = 1e-6f;
constexpr float L2E = 1.4426950408889634f;

constexpr size_t MiB = 1u << 20;
constexpr size_t WS_CTL = 0, CTL_ZERO_BYTES = 128 * 1024;
constexpr size_t WS_FLAG = 32 * 1024;
constexpr size_t WS_TMO = 24 * 1024;
constexpr size_t WS_SLAB = 424 * MiB;
constexpr size_t WS_MOD = 1 * MiB;
constexpr size_t WS_E01 = 2 * MiB, WS_G01 = 2 * MiB + 256 * 1024, WS_CNTW = 2 * MiB + 512 * 1024;
constexpr size_t WS_LIST = 3 * MiB, WS_LGATE = 3 * MiB + 256 * 1024, WS_PEXP = 3 * MiB + 512 * 1024;
constexpr size_t WS_WPOOL = 4 * MiB, WS_AWS = 4 * MiB + 512 * 1024;
constexpr size_t WS_WIN = 6 * MiB, WS_WOUT = 15 * MiB, WS_WGU = 19 * MiB, WS_WD = 30 * MiB;
constexpr size_t WS_MGU = 36 * MiB, WS_MD = 92 * MiB;
constexpr size_t WS_H8 = 120 * MiB;
constexpr size_t WS_Y = 136 * MiB;
constexpr size_t WS_HB = 204 * MiB, WS_XMC = 238 * MiB, WS_XC1 = 242 * MiB, WS_X1 = 246 * MiB, WS_PROJ = 310 * MiB, WS_MIX = 387 * MiB;
constexpr size_t WS_HFF = 310 * MiB;
constexpr size_t WS_HFM = 246 * MiB;
constexpr size_t WS_END = 488 * MiB;
static_assert(WS_HFM + (size_t)MAXP * 256 * DFE <= WS_SLAB && WS_MD + (size_t)NE * D * DFE <= WS_H8 && WS_MGU + (size_t)NE * 2 * DFE * D <= WS_MD, "ws map");
static_assert(WS_MIX + (size_t)R * D * 2 <= WS_SLAB && WS_PROJ + (size_t)R * INC * 2 <= WS_MIX && WS_HFF + (size_t)R * DFF * 2 <= WS_SLAB, "ws map");
constexpr int SC_WGU = 121, SC_WD = 120, SC_ACT = 125;
constexpr float F8_WGU = 64.f, F8_WD = 128.f, F8_ACT = 4.f;

constexpr int RING_BYTES = 131072;
constexpr int LDSCTL_OFF = RING_BYTES;
constexpr int LDS_BYTES = 147456;
constexpr int NWAVES = 8;

__device__ __forceinline__ float bf2f(unsigned short h) { return __uint_as_float((unsigned)h << 16); }
__device__ __forceinline__ unsigned cvt_pk_bf16(float lo, float hi) { unsigned r; asm volatile("v_cvt_pk_bf16_f32 %0, %1, %2" : "=v"(r) : "v"(lo), "v"(hi)); return r; }
__device__ __forceinline__ float silu_f(float x) { return x * __builtin_amdgcn_rcpf(1.f + __builtin_amdgcn_exp2f(-x * L2E)); }
__device__ __forceinline__ float wave_sum(float v) {
#pragma unroll
    for (int o = 1; o < 64; o <<= 1) v += __shfl_xor(v, o);
    return v;
}
__device__ __forceinline__ f32x2 gelu_pk(f32x2 v) {
    const f32x2 av = __builtin_elementwise_abs(v), d = av * 0.2316418882f + 1.0f;
    f32x2 t; t.x = __builtin_amdgcn_rcpf(d.x); t.y = __builtin_amdgcn_rcpf(d.y);
    f32x2 q = t * 0.5307027145f + (-0.7265760135f); q = q * t + 0.7107068705f; q = q * t + (-0.142248368f); q = q * t + 0.127414796f; q = q * t;
    const f32x2 s = (v * v) * (-0.72134752044f);
    f32x2 e; e.x = __builtin_amdgcn_exp2f(s.x); e.y = __builtin_amdgcn_exp2f(s.y);
    const f32x2 m = v * (q * e), r = v - m;
    f32x2 o; o.x = v.x < 0.f ? m.x : r.x; o.y = v.y < 0.f ? m.y : r.y; return o;
}
__device__ __forceinline__ void unpack8(const u32x4 w, float (&f)[8]) {
    f[0] = __uint_as_float(w.x << 16); f[1] = __uint_as_float(w.x & 0xffff0000u); f[2] = __uint_as_float(w.y << 16); f[3] = __uint_as_float(w.y & 0xffff0000u);
    f[4] = __uint_as_float(w.z << 16); f[5] = __uint_as_float(w.z & 0xffff0000u); f[6] = __uint_as_float(w.w << 16); f[7] = __uint_as_float(w.w & 0xffff0000u);
}

__device__ __forceinline__ unsigned pk4_f8(float a, float b, float c, float d) {
    a = __builtin_amdgcn_fmed3f(a, -448.f, 448.f); b = __builtin_amdgcn_fmed3f(b, -448.f, 448.f); c = __builtin_amdgcn_fmed3f(c, -448.f, 448.f); d = __builtin_amdgcn_fmed3f(d, -448.f, 448.f);
    int p = __builtin_amdgcn_cvt_pk_fp8_f32(a, b, 0, false); p = __builtin_amdgcn_cvt_pk_fp8_f32(c, d, p, true); return (unsigned)p; }
namespace pg8 {
constexpr int BM = 256, BK = 64, HALF = 128, HTB = HALF * BK * 2, STAGE_BYTES = 8 * HTB, NXCD = 8, WGM = 8;
__host__ __device__ __forceinline__ int lds_byte(int r, int c) { const int st = (r >> 4) * 2 + (c >> 5), rr = r & 15, cc = c & 31, ob = rr * 64 + cc * 2; return st * 1024 + (ob ^ (((ob >> 9) & 1) << 5)); }
__host__ __device__ __forceinline__ void stage_rc(int b, int& Rr, int& C) { const int st = b / 1024, sb = b % 1024, swz = sb ^ (((sb >> 9) & 1) << 5); Rr = (st >> 1) * 16 + swz / 64; C = (st & 1) * 32 + (swz % 64) / 2; }
__host__ __device__ __forceinline__ int perm32(int rho) { const int n = rho >> 4, i = rho & 15; return 8 * (i >> 2) + 4 * n + (i & 3); }

typedef int v8i_t __attribute__((ext_vector_type(8)));
__device__ __forceinline__ v8i_t cat16(const bf16x8 a, const bf16x8 b) { const u32x4 x = __builtin_bit_cast(u32x4, a), y = __builtin_bit_cast(u32x4, b); return (v8i_t){(int)x[0], (int)x[1], (int)x[2], (int)x[3], (int)y[0], (int)y[1], (int)y[2], (int)y[3]}; }
union Frag { bf16x8 q[2]; v8i_t w; };
struct Unit { int pm, pn, pnl, kt0, nkt, mode; };
struct Gemm { const void* A; const void* Bt; int K; const int* rows; int sa, sb; };

struct DenseDec {
    int nM, nN;
    __device__ __forceinline__ void operator()(int u, Unit& p) const { const int nig = WGM * nN, gid = u / nig, r = u - gid * nig, fm = gid * WGM, gsz = (nM - fm) < WGM ? (nM - fm) : WGM;
        const int q = r / gsz; p.pm = fm + (r - q * gsz); p.pnl = q; p.pn = q; }
};
struct MoeDec {
    int nM, nN; const LAS int* pexp;
    __device__ __forceinline__ void operator()(int u, Unit& p) const { const int nig = WGM * nN, gid = u / nig, r = u - gid * nig, fm = gid * WGM, gsz = (nM - fm) < WGM ? (nM - fm) : WGM;
        const int q = r / gsz; p.pm = fm + (r - q * gsz); p.pnl = q; p.pn = pexp[p.pm] * nN + q; }
};
template <class Dec> struct StreamK {
    Dec dec; int P, lo, hi, rank, U, G, wg; bool dp;
    __device__ __forceinline__ void init(const Dec& d, int U_, int P_, int G_, int rank_, int wg_, bool dp_) { dec = d; P = P_; rank = rank_; U = U_; G = G_; wg = wg_; dp = dp_;
        const long TP = (long)U_ * P_; lo = (int)(TP * rank_ / G_); hi = (int)(TP * (rank_ + 1) / G_); }
    __device__ __forceinline__ int unit_at(int q) const {
        int x = (8 * q) / U; if (q >= ((x + 1) * U) / 8) ++x;
        const int ulo = (x * U) / 8, n = ((x + 1) * U) / 8 - ulo, L = n / 32, rem = n - 32 * L, w = q - ulo;
        if (L == 0) return q;
        int j, t; if (w < rem * (L + 1)) { j = w / (L + 1); t = w - j * (L + 1); } else { const int w2 = w - rem * (L + 1); j = w2 / L; t = w2 - j * L; j += rem; }
        return ulo + t * 32 + j;
    }
    __device__ __forceinline__ bool next(int i, Unit& p) const {
        if (dp) { const int Lq = i * G + wg; if (Lq >= U) return false;
            int wgid = Lq; { const int q8 = U / NXCD, r8 = U % NXCD, xcd = wgid % NXCD, off = wgid / NXCD; wgid = (xcd < r8 ? xcd * (q8 + 1) : r8 * (q8 + 1) + (xcd - r8) * q8) + off; }
            dec(wgid, p); p.kt0 = 0; p.nkt = 2 * P; p.mode = 0; return true; }
        const int q = lo / P + i; if (q * P >= hi) return false;
        int bg = lo - q * P; bg = bg < 0 ? 0 : bg; int en = hi - q * P; en = en > P ? P : en;
        dec(unit_at(q), p); p.kt0 = 2 * bg; p.nkt = 2 * (en - bg); p.mode = bg > 0 ? 2 : (en < P ? 1 : 0); return true;
    }
};
struct SlabCtl { unsigned char* slab; unsigned* flag; unsigned epoch; unsigned* tmo; };

template <class Epi, class Sched, bool GATHER, bool F8 = false>
__device__ __forceinline__ void gemm_phase(LAS unsigned char* lds, const Gemm g, const Sched& S, const Epi& E, const SlabCtl sk) {
    const int tid = threadIdx.x, wid = __builtin_amdgcn_readfirstlane(tid >> 6), lane = tid & 63, wr = wid >> 2, wc = wid & 3, fr = lane & 15, fq = lane >> 4;
    const int K = g.K, KB = F8 ? K : 2 * K;
    const unsigned kstep = (unsigned)(BK * 2);
    const unsigned hstep = (unsigned)HALF * KB;
    const unsigned tstep = 2 * hstep;
    const __amdgpu_buffer_rsrc_t rsA = __builtin_amdgcn_make_buffer_rsrc((void*)g.A, 0, 0xffffffff, 0x00020000), rsB = __builtin_amdgcn_make_buffer_rsrc((void*)g.Bt, 0, 0xffffffff, 0x00020000);
    int sR[2], sC[2];
    unsigned voffB[2], voffA[2][2], voffAn[2][2];
#pragma unroll
    for (int i = 0; i < 2; ++i) { stage_rc(tid * 16 + i * 8192, sR[i], sC[i]); const int Rb = Epi::PERM ? ((sR[i] & ~31) + perm32(sR[i] & 31)) : sR[i];
        voffB[i] = (unsigned)(Rb * KB + sC[i] * 2);
        voffA[0][i] = (unsigned)(sR[i] * KB + sC[i] * 2); voffA[1][i] = voffA[0][i] + hstep; voffAn[0][i] = voffA[0][i]; voffAn[1][i] = voffA[1][i]; }
    const unsigned ldsw = (unsigned)wid * 1024u;
    const int aoff = lds_byte(wr * 64 + fr, fq * 8), boff = lds_byte(wc * 32 + fr, fq * 8);
#define PG8_SA(b, h) (((b) * 2 + (h)) * HTB)
#define PG8_SB(b, h) ((4 + (b) * 2 + (h)) * HTB)
#define PG8_STAGE(bufoff, rs, soff, voff) do { _Pragma("unroll") for (int _i = 0; _i < 2; ++_i) \
        __builtin_amdgcn_raw_ptr_buffer_load_lds(rs, (LAS void*)(lds + (bufoff) + ldsw + _i * 8192), 16, (voff)[_i], (soff), 0, 0); } while (0)
#define PG8_LDA(dst, b, h) do { _Pragma("unroll") for (int m = 0; m < 4; ++m) { if constexpr (F8) dst[m].w = cat16(*(const LAS bf16x8*)(lds + PG8_SA(b, h) + aoff + m * 2048), *(const LAS bf16x8*)(lds + PG8_SA(b, h) + aoff + m * 2048 + 1024)); \
        else { _Pragma("unroll") for (int k = 0; k < 2; ++k) dst[m].q[k] = *(const LAS bf16x8*)(lds + PG8_SA(b, h) + aoff + m * 2048 + k * 1024); } } } while (0)
#define PG8_LDB(dst, b, h) do { _Pragma("unroll") for (int n = 0; n < 2; ++n) { if constexpr (F8) dst[n].w = cat16(*(const LAS bf16x8*)(lds + PG8_SB(b, h) + boff + n * 2048), *(const LAS bf16x8*)(lds + PG8_SB(b, h) + boff + n * 2048 + 1024)); \
        else { _Pragma("unroll") for (int k = 0; k < 2; ++k) dst[n].q[k] = *(const LAS bf16x8*)(lds + PG8_SB(b, h) + boff + n * 2048 + k * 1024); } } } while (0)
#define PG8_MMA(ai, bj, At, Bt) do { __builtin_amdgcn_s_setprio(1); _Pragma("unroll") for (int m = 0; m < 4; ++m) _Pragma("unroll") for (int n = 0; n < 2; ++n) { \
        if constexpr (F8) { asm volatile("v_mfma_scale_f32_16x16x128_f8f6f4 %0, %1, %2, %0, %3, %4 op_sel_hi:[0,0,0]" : "+v"(acc[ai][bj][m][n]) : "v"(Bt[n].w), "v"(At[m].w), "v"(g.sa), "v"(g.sb)); } \
        else { _Pragma("unroll") for (int k = 0; k < 2; ++k) acc[ai][bj][m][n] = __builtin_amdgcn_mfma_f32_16x16x32_bf16(Bt[n].q[k], At[m].q[k], acc[ai][bj][m][n], 0, 0, 0); } } \
        __builtin_amdgcn_s_setprio(0); } while (0)
#define PG8_WAIT_V(n) asm volatile("s_waitcnt vmcnt(" #n ")" ::: "memory")
#define PG8_WAIT_L(n) asm volatile("s_waitcnt lgkmcnt(" #n ")" ::: "memory")
#define PG8_BAR __builtin_amdgcn_s_barrier()
#define PG8_SCHED __builtin_amdgcn_sched_barrier(0)
#define PG8_GATHER(dst, u) do { _Pragma("unroll") for (int _h = 0; _h < 2; ++_h) _Pragma("unroll") for (int _i = 0; _i < 2; ++_i) { \
        const int _e = g.rows[(u).pm * BM + _h * HALF + sR[_i]]; const int _t = _e < 0 ? 0 : (_e >> 1); dst[_h][_i] = (unsigned)(_t * KB + sC[_i] * 2); } } while (0)
    Unit cur, nxt; int ui = 0;
    if (!S.next(0, cur)) return;
    f32x4 acc[2][2][4][2];
#pragma unroll
    for (int a = 0; a < 2; ++a)
#pragma unroll
        for (int b = 0; b < 2; ++b)
#pragma unroll
            for (int m = 0; m < 4; ++m)
#pragma unroll
                for (int n = 0; n < 2; ++n) acc[a][b][m][n] = (f32x4){0.f, 0.f, 0.f, 0.f};
    Frag At[4], B0[2], B1[2];
    if constexpr (GATHER) PG8_GATHER(voffA, cur);
    unsigned cA = (GATHER ? 0u : (unsigned)cur.pm * tstep) + (unsigned)cur.kt0 * kstep, cB = (unsigned)cur.pn * tstep + (unsigned)cur.kt0 * kstep;
    PG8_STAGE(PG8_SB(0, 0), rsB, cB, voffB); PG8_STAGE(PG8_SB(0, 1), rsB, cB + hstep, voffB); PG8_STAGE(PG8_SA(0, 0), rsA, cA, voffA[0]); PG8_STAGE(PG8_SA(0, 1), rsA, cA, voffA[1]);
    if (wr == 1) PG8_BAR;
    PG8_WAIT_V(2); PG8_BAR;
    PG8_STAGE(PG8_SB(1, 0), rsB, cB + kstep, voffB); PG8_STAGE(PG8_SA(1, 0), rsA, cA + kstep, voffA[0]); PG8_STAGE(PG8_SB(1, 1), rsB, cB + hstep + kstep, voffB);
    PG8_WAIT_V(6); PG8_BAR;
    for (;;) {
        const bool has_next = S.next(ui + 1, nxt);
        const unsigned nA = has_next ? (GATHER ? 0u : (unsigned)nxt.pm * tstep) + (unsigned)nxt.kt0 * kstep : cA, nB = has_next ? (unsigned)nxt.pn * tstep + (unsigned)nxt.kt0 * kstep : cB;
        const int nt = cur.nkt;
        if constexpr (GATHER) { if (has_next) PG8_GATHER(voffAn, nxt); else {
#pragma unroll
            for (int h = 0; h < 2; ++h)
#pragma unroll
                for (int i = 0; i < 2; ++i) voffAn[h][i] = voffA[h][i]; } }
#pragma unroll 1
        for (int t = 0; t < nt; t += 2) {
            const bool last = (t == nt - 2);
            const unsigned a1 = cA + (unsigned)(t + 1) * kstep;
            const unsigned a2 = last ? nA : cA + (unsigned)(t + 2) * kstep, b2 = last ? nB : cB + (unsigned)(t + 2) * kstep;
            const unsigned a3 = a2 + kstep, b3 = b2 + kstep;
            unsigned vo2[2][2];
#pragma unroll
            for (int h = 0; h < 2; ++h)
#pragma unroll
                for (int i = 0; i < 2; ++i) vo2[h][i] = (GATHER && last) ? voffAn[h][i] : voffA[h][i];
            PG8_LDB(B0, 0, 0); PG8_LDB(B1, 0, 1); PG8_SCHED; PG8_LDA(At, 0, 0); PG8_STAGE(PG8_SA(1, 1), rsA, a1, voffA[1]);
            PG8_WAIT_V(8); PG8_WAIT_L(0); PG8_BAR; PG8_MMA(0, 0, At, B0); PG8_MMA(0, 1, At, B1); PG8_BAR; PG8_SCHED;
            PG8_LDA(At, 0, 1); PG8_STAGE(PG8_SB(0, 0), rsB, b2, voffB); PG8_STAGE(PG8_SB(0, 1), rsB, b2 + hstep, voffB); PG8_STAGE(PG8_SA(0, 0), rsA, a2, vo2[0]);
            PG8_WAIT_V(8); PG8_WAIT_L(0); PG8_BAR; PG8_MMA(1, 0, At, B0); PG8_MMA(1, 1, At, B1); PG8_BAR; PG8_SCHED;
            PG8_LDB(B0, 1, 0); PG8_LDB(B1, 1, 1); PG8_SCHED; PG8_LDA(At, 1, 0); PG8_STAGE(PG8_SA(0, 1), rsA, a2, vo2[1]);
            PG8_WAIT_V(8); PG8_WAIT_L(0); PG8_BAR; PG8_MMA(0, 0, At, B0); PG8_MMA(0, 1, At, B1); PG8_BAR; PG8_SCHED;
            PG8_LDA(At, 1, 1); PG8_STAGE(PG8_SB(1, 0), rsB, b3, voffB); PG8_STAGE(PG8_SB(1, 1), rsB, b3 + hstep, voffB); PG8_STAGE(PG8_SA(1, 0), rsA, a3, vo2[0]);
            PG8_WAIT_V(8); PG8_WAIT_L(0); PG8_BAR; PG8_MMA(1, 0, At, B0); PG8_MMA(1, 1, At, B1); PG8_BAR; PG8_SCHED;
        }
        if (wr == 0) PG8_BAR;
        if constexpr (F8) asm volatile("s_nop 15\n\ts_nop 15" ::: "memory");
        if (cur.mode == 2) {
            const __amdgpu_buffer_rsrc_t rsS = __builtin_amdgcn_make_buffer_rsrc((void*)sk.slab, 0, 0xffffffff, 0x00020000); const unsigned so = (unsigned)S.rank * 131072u;
#pragma unroll
            for (int a = 0; a < 2; ++a)
#pragma unroll
                for (int b = 0; b < 2; ++b)
#pragma unroll
                    for (int m = 0; m < 4; ++m) { const f32x4 v0 = acc[a][b][m][0], v1 = acc[a][b][m][1];
                        u32x4 w; w.x = cvt_pk_bf16(v0[0], v0[1]); w.y = cvt_pk_bf16(v0[2], v0[3]); w.z = cvt_pk_bf16(v1[0], v1[1]); w.w = cvt_pk_bf16(v1[2], v1[3]);
                        __builtin_amdgcn_raw_buffer_store_b128(w, rsS, (unsigned)tid * 16u, so + (unsigned)(((a * 2 + b) * 4 + m) * 8192), 16); }
            asm volatile("s_waitcnt vmcnt(0)" ::: "memory"); PG8_BAR; asm volatile("" ::: "memory");
            if (tid == 0) __hip_atomic_store(sk.flag + S.rank * 64, sk.epoch, __ATOMIC_RELAXED, __HIP_MEMORY_SCOPE_AGENT);
        } else {
            if (cur.mode == 1) {
                if (wid == 0) { unsigned sp = 0;
                    while ((unsigned)__builtin_amdgcn_readfirstlane(__hip_atomic_load(sk.flag + (S.rank + 1) * 64, __ATOMIC_RELAXED, __HIP_MEMORY_SCOPE_AGENT)) != sk.epoch) {
                        __builtin_amdgcn_s_sleep(2); if (++sp > (1u << 22)) { if (tid == 0) __hip_atomic_store(sk.tmo, 1u, __ATOMIC_RELAXED, __HIP_MEMORY_SCOPE_AGENT); break; } }
                    __builtin_amdgcn_fence(__ATOMIC_ACQUIRE, "agent"); asm volatile("s_waitcnt vmcnt(0)" ::: "memory"); }
                asm volatile("" ::: "memory"); PG8_BAR; asm volatile("" ::: "memory");
                const __amdgpu_buffer_rsrc_t rsL = __builtin_amdgcn_make_buffer_rsrc((void*)sk.slab, 0, 0xffffffff, 0x00020000); const unsigned sl = (unsigned)(S.rank + 1) * 131072u;
#pragma unroll
                for (int a = 0; a < 2; ++a)
#pragma unroll
                    for (int b = 0; b < 2; ++b)
#pragma unroll
                        for (int m = 0; m < 4; ++m) { const u32x4 w = __builtin_amdgcn_raw_buffer_load_b128(rsL, (unsigned)tid * 16u, sl + (unsigned)(((a * 2 + b) * 4 + m) * 8192), 0);
                            f32x4 p0, p1; p0[0] = __uint_as_float(w.x << 16); p0[1] = __uint_as_float(w.x & 0xffff0000u); p0[2] = __uint_as_float(w.y << 16); p0[3] = __uint_as_float(w.y & 0xffff0000u);
                            p1[0] = __uint_as_float(w.z << 16); p1[1] = __uint_as_float(w.z & 0xffff0000u); p1[2] = __uint_as_float(w.w << 16); p1[3] = __uint_as_float(w.w & 0xffff0000u);
                            acc[a][b][m][0] += p0; acc[a][b][m][1] += p1; }
            }
            E(acc, cur, wr, wc, fr, fq);
        }
        if (!has_next) break;
#pragma unroll
        for (int a = 0; a < 2; ++a)
#pragma unroll
            for (int b = 0; b < 2; ++b)
#pragma unroll
                for (int m = 0; m < 4; ++m)
#pragma unroll
                    for (int n = 0; n < 2; ++n) acc[a][b][m][n] = (f32x4){0.f, 0.f, 0.f, 0.f};
        cur = nxt; cA = nA; cB = nB; ++ui;
        if constexpr (GATHER) {
#pragma unroll
            for (int h = 0; h < 2; ++h)
#pragma unroll
                for (int i = 0; i < 2; ++i) voffA[h][i] = voffAn[h][i]; }
        if (wr == 1) PG8_BAR;
    }
    PG8_WAIT_V(0);
    PG8_BAR;
#undef PG8_SA
#undef PG8_SB
#undef PG8_STAGE
#undef PG8_LDA
#undef PG8_LDB
#undef PG8_MMA
#undef PG8_WAIT_V
#undef PG8_WAIT_L
#undef PG8_BAR
#undef PG8_SCHED
#undef PG8_GATHER
}

struct EpiInProj {
    static constexpr bool PERM = true;
    bf16_t* P; const float* qg; const float* kg;
    __device__ __forceinline__ void operator()(const f32x4 (&acc)[2][2][4][2], const Unit& u, int wr, int wc, int fr, int fq) const {
        const int pn = u.pnl; const int row0 = u.pm * BM + wr * 64 + fr;
        if (pn < 3 || pn >= 7) {
            const int col0 = pn * 256 + wc * 32 + 8 * fq;
#pragma unroll
            for (int ai = 0; ai < 2; ++ai)
#pragma unroll
                for (int m = 0; m < 4; ++m) { bf16_t* rowp = P + (size_t)(row0 + ai * HALF + m * 16) * INC + col0;
#pragma unroll
                    for (int bj = 0; bj < 2; ++bj) { f32x4 v0 = acc[ai][bj][m][0], v1 = acc[ai][bj][m][1];
                        if (pn < 2) { f32x2 a = gelu_pk((f32x2){v0[0], v0[1]}), b = gelu_pk((f32x2){v0[2], v0[3]}), c = gelu_pk((f32x2){v1[0], v1[1]}), d = gelu_pk((f32x2){v1[2], v1[3]});
                            v0 = (f32x4){a.x, a.y, b.x, b.y}; v1 = (f32x4){c.x, c.y, d.x, d.y}; }
                        u32x4 w; w.x = cvt_pk_bf16(v0[0], v0[1]); w.y = cvt_pk_bf16(v0[2], v0[3]); w.z = cvt_pk_bf16(v1[0], v1[1]); w.w = cvt_pk_bf16(v1[2], v1[3]);
                        *(u32x4*)(rowp + bj * HALF) = w; } }
        } else {
            const bool isq = pn < 5; const float* g = isq ? qg : kg; const float sc = isq ? 0.125f : 1.0f;
            f32x4 gv[2][2];
#pragma unroll
            for (int bj = 0; bj < 2; ++bj)
#pragma unroll
                for (int n = 0; n < 2; ++n) gv[bj][n] = *(const f32x4*)(g + bj * 32 + 8 * fq + 4 * n) * sc;
            const int col0 = pn * 256 + wc * 64 + 8 * fq;
#pragma unroll
            for (int ai = 0; ai < 2; ++ai)
#pragma unroll
                for (int m = 0; m < 4; ++m) { float ss = 0.f;
#pragma unroll
                    for (int bj = 0; bj < 2; ++bj)
#pragma unroll
                        for (int n = 0; n < 2; ++n) { const f32x4 x = acc[ai][bj][m][n]; ss += (x[0] * x[0] + x[1] * x[1]) + (x[2] * x[2] + x[3] * x[3]); }
                    ss += __shfl_xor(ss, 16); ss += __shfl_xor(ss, 32);
                    const float rs = __builtin_amdgcn_rsqf(ss * (1.0f / 64.0f) + EPS);
                    bf16_t* rowp = P + (size_t)(row0 + ai * HALF + m * 16) * INC + col0;
#pragma unroll
                    for (int bj = 0; bj < 2; ++bj) { const f32x4 v0 = acc[ai][bj][m][0] * rs * gv[bj][0], v1 = acc[ai][bj][m][1] * rs * gv[bj][1];
                        u32x4 w; w.x = cvt_pk_bf16(v0[0], v0[1]); w.y = cvt_pk_bf16(v0[2], v0[3]); w.z = cvt_pk_bf16(v1[0], v1[1]); w.w = cvt_pk_bf16(v1[2], v1[3]);
                        *(u32x4*)(rowp + bj * 32) = w; } }
        }
    }
};
template <bool OUT8> struct EpiSwiGLU {
    static constexpr bool PERM = true;
    void* H; int ldc;
    __device__ __forceinline__ void operator()(const f32x4 (&acc)[2][2][4][2], const Unit& u, int wr, int wc, int fr, int fq) const {
        const int row0 = u.pm * BM + wr * 64 + fr, col0 = u.pnl * 128 + wc * 32 + 8 * fq;
#pragma unroll
        for (int ai = 0; ai < 2; ++ai)
#pragma unroll
            for (int m = 0; m < 4; ++m) { const f32x4 g0 = acc[ai][0][m][0], g1 = acc[ai][0][m][1], u0 = acc[ai][1][m][0], u1 = acc[ai][1][m][1];
                const float h0 = silu_f(g0[0]) * u0[0], h1 = silu_f(g0[1]) * u0[1], h2 = silu_f(g0[2]) * u0[2], h3 = silu_f(g0[3]) * u0[3];
                const float h4 = silu_f(g1[0]) * u1[0], h5 = silu_f(g1[1]) * u1[1], h6 = silu_f(g1[2]) * u1[2], h7 = silu_f(g1[3]) * u1[3];
                const size_t off = (size_t)(row0 + ai * HALF + m * 16) * ldc + col0;
                if constexpr (OUT8) { u32x2 w; w.x = pk4_f8(h0 * F8_ACT, h1 * F8_ACT, h2 * F8_ACT, h3 * F8_ACT); w.y = pk4_f8(h4 * F8_ACT, h5 * F8_ACT, h6 * F8_ACT, h7 * F8_ACT); *(u32x2*)((unsigned char*)H + off) = w; }
                else { u32x4 w; w.x = cvt_pk_bf16(h0, h1); w.y = cvt_pk_bf16(h2, h3); w.z = cvt_pk_bf16(h4, h5); w.w = cvt_pk_bf16(h6, h7); *(u32x4*)((bf16_t*)H + off) = w; } }
    }
};
struct EpiResGate {
    static constexpr bool PERM = false;
    const float* res_l; const float* res_c; float* out_l; float* out_c; const float* gate;
    __device__ __forceinline__ void operator()(const f32x4 (&acc)[2][2][4][2], const Unit& u, int wr, int wc, int fr, int fq) const {
        const bool lat = u.pm < NLAT / BM; const int cond = lat ? (u.pm >> 4) : 4;
        const float* res = lat ? res_l : res_c; float* out = lat ? out_l : out_c;
        const int rowl = (lat ? u.pm : u.pm - NLAT / BM) * BM + wr * 64 + fr, col0 = u.pnl * BM + wc * 32 + 4 * fq;
        f32x4 gv[2][2];
#pragma unroll
        for (int bj = 0; bj < 2; ++bj)
#pragma unroll
            for (int n = 0; n < 2; ++n) gv[bj][n] = *(const f32x4*)(gate + (size_t)cond * 6 * D + col0 + bj * HALF + n * 16);
#pragma unroll
        for (int ai = 0; ai < 2; ++ai)
#pragma unroll
            for (int m = 0; m < 4; ++m) { const size_t off = (size_t)(rowl + ai * HALF + m * 16) * D + col0;
#pragma unroll
                for (int bj = 0; bj < 2; ++bj)
#pragma unroll
                    for (int n = 0; n < 2; ++n) { const f32x4 bs = *(const f32x4*)(res + off + bj * HALF + n * 16); *(f32x4*)(out + off + bj * HALF + n * 16) = bs + gv[bj][n] * acc[ai][bj][m][n]; }
                if (m & 1) asm volatile("" ::: "memory"); }
    }
};
struct EpiMoeDown {
    static constexpr bool PERM = true;
    bf16_t* Y; const int* rows; const float* lgate;
    __device__ __forceinline__ void operator()(const f32x4 (&acc)[2][2][4][2], const Unit& u, int wr, int wc, int fr, int fq) const {
        const int prow0 = u.pm * BM + wr * 64 + fr, col0 = u.pnl * BM + wc * 32 + 8 * fq;
#pragma unroll
        for (int ai = 0; ai < 2; ++ai)
#pragma unroll
            for (int m = 0; m < 4; ++m) { const int prow = prow0 + ai * HALF + m * 16; const int ent = rows[prow];
                if (ent >= 0) { const float gt = lgate[prow]; bf16_t* dst = Y + ((size_t)(ent & 1) * NLAT + (size_t)(ent >> 1)) * D + col0;
#pragma unroll
                    for (int bj = 0; bj < 2; ++bj) { const f32x4 v0 = acc[ai][bj][m][0] * gt, v1 = acc[ai][bj][m][1] * gt;
                        u32x4 w; w.x = cvt_pk_bf16(v0[0], v0[1]); w.y = cvt_pk_bf16(v0[2], v0[3]); w.z = cvt_pk_bf16(v1[0], v1[1]); w.w = cvt_pk_bf16(v1[2], v1[3]);
                        *(u32x4*)(dst + bj * HALF) = w; } } }
    }
};
}

#define XB_TMO      128
#define XB_XCNT(j)  (256  + 64 * (j))
#define XB_XSUB(j)  (1280 + 64 * (j))
#define XB_XGEN(j)  (2304 + 64 * (j))
#define XB_TOP      3328
#define XB_TOPGEN   3392
#define XCD_BAR_WORDS 3456
#define XB_SPIN_CAP (1u << 18)
__device__ __forceinline__ unsigned xb_ld(unsigned* p)              { return __hip_atomic_load(p, __ATOMIC_RELAXED, __HIP_MEMORY_SCOPE_AGENT); }
__device__ __forceinline__ unsigned xb_add(unsigned* p, unsigned v) { return __hip_atomic_fetch_add(p, v, __ATOMIC_RELAXED, __HIP_MEMORY_SCOPE_AGENT); }
__device__ __forceinline__ unsigned xb_xcc_id() { return (unsigned)__builtin_amdgcn_s_getreg((3 << 11) | 20) & 0xFu; }
#define XB_SPIN(cond, bar) do { unsigned _sp = 0; while (cond) { __builtin_amdgcn_s_sleep(1); \
    if ((++_sp & 255u) == 0u) { if (xb_ld(&(bar)[XB_TMO])) break; if (_sp > XB_SPIN_CAP) { atomicAdd(&(bar)[XB_TMO], 1u); break; } } } } while (0)
struct XcdBarrier { unsigned* bar; unsigned x; volatile LAS unsigned* st; };
__device__ __forceinline__ XcdBarrier xcd_barrier_post(unsigned* bar, volatile LAS unsigned* st) {
    XcdBarrier b; b.bar = bar; b.x = xb_xcc_id(); b.st = st;
    if (threadIdx.x == 0) (void)xb_add(&bar[XB_XCNT(b.x)], 1u);
    return b;
}
__device__ __forceinline__ void xcd_barrier_complete(unsigned* bar, unsigned x, unsigned& nloc, unsigned& nx) {
    const unsigned G = gridDim.x * gridDim.y * gridDim.z;
    unsigned sum, cnt, mine, sp = 0u;
    for (;;) {
        sum = 0u; cnt = 0u; mine = 0u;
#pragma unroll
        for (unsigned j = 0; j < 16; ++j) { const unsigned c = xb_ld(&bar[XB_XCNT(j)]); sum += c; cnt += (c > 0u) ? 1u : 0u; mine = (j == x) ? c : mine; }
        if (sum == G) break;
        __builtin_amdgcn_s_sleep(1);
        if ((++sp & 255u) == 0u) { if (xb_ld(&bar[XB_TMO])) break; if (sp > XB_SPIN_CAP) { atomicAdd(&bar[XB_TMO], 1u); break; } }
    }
    nloc = mine > 0u ? mine : 1u; nx = cnt > 0u ? cnt : 1u;
}
__device__ __forceinline__ void xcd_barrier(const XcdBarrier& b) {
    asm volatile("s_waitcnt vmcnt(0)" ::: "memory");
    __syncthreads();
    if (threadIdx.x == 0) {
        unsigned* bar = b.bar;
        __builtin_amdgcn_s_waitcnt(0);
        unsigned nloc = b.st[0], nx = b.st[1];
        if (nloc == 0u) { xcd_barrier_complete(bar, b.x, nloc, nx); b.st[0] = nloc; b.st[1] = nx; }
        const unsigned old = xb_add(&bar[XB_XSUB(b.x)], 1u);
        const unsigned gen = old / nloc;
        if (old + 1u == (gen + 1u) * nloc) {
            __builtin_amdgcn_fence(__ATOMIC_RELEASE, "agent");
            asm volatile("s_waitcnt vmcnt(0)" ::: "memory");
            const unsigned og = xb_add(&bar[XB_TOP], 1u);
            const unsigned tg = og / nx;
            if (og + 1u == (tg + 1u) * nx) xb_add(&bar[XB_TOPGEN], 1u);
            else XB_SPIN(xb_ld(&bar[XB_TOPGEN]) == tg, bar);
            __builtin_amdgcn_fence(__ATOMIC_ACQUIRE, "agent");
            xb_add(&bar[XB_XGEN(b.x)], 1u);
            asm volatile("s_waitcnt vmcnt(0)" ::: "memory");
        } else {
            XB_SPIN(xb_ld(&bar[XB_XGEN(b.x)]) == gen, bar);
            __builtin_amdgcn_fence(__ATOMIC_ACQUIRE, "agent");
            asm volatile("s_waitcnt vmcnt(0)" ::: "memory");
        }
    }
    __syncthreads();
}

struct Args {
    const float* in[26]; float* out; unsigned char* ws;
    int ph_lo, ph_hi;
};
struct Ctx {
    LAS unsigned char* lds; int tid, lane, wave, G, wg;
    unsigned char* ws; const float* const* in; float* out;
};

__device__ __forceinline__ int dest_row(int kind, int n) {
    if (kind == 1) { if (n >= OFF_Q && n < OFF_VV) { const int t = n >> 8, w = n & 255, h = w >> 6, d = w & 63; return (t << 8) + ((d >> 5) << 7) + (h << 5) + (d & 31); } return n; }
    if (kind == 2) return ((n >> 7) << 8) + (n & 127);
    if (kind == 3) return ((n >> 7) << 8) + 128 + (n & 127);
    return n;
}
__device__ __forceinline__ void cvt_item(const float* W, int K, int N, bf16_t* WT, int kind, LAS float* scr, int item, int lane) {
    const int nkb = K / 32, nb = item / nkb, kb = item - nb * nkb, k0 = kb * 32, n0 = nb * 64;
    const float* src = W + (size_t)(k0 + (lane >> 4)) * N + n0 + (lane & 15) * 4;
    f32x4 v[8];
#pragma unroll
    for (int it = 0; it < 8; ++it) v[it] = *(const f32x4*)(src + (size_t)it * 4 * N);
#pragma unroll
    for (int it = 0; it < 8; ++it) { LAS float* d = scr + (it * 4 + (lane >> 4)) * 65 + (lane & 15) * 4; d[0] = v[it][0]; d[1] = v[it][1]; d[2] = v[it][2]; d[3] = v[it][3]; }
    asm volatile("s_waitcnt lgkmcnt(0)" ::: "memory");
    const int c = lane & 3;
#pragma unroll
    for (int it = 0; it < 4; ++it) { const int nl = it * 16 + (lane >> 2); const LAS float* s = scr + (8 * c) * 65 + nl;
        u32x4 o; o.x = cvt_pk_bf16(s[0], s[65]); o.y = cvt_pk_bf16(s[2 * 65], s[3 * 65]); o.z = cvt_pk_bf16(s[4 * 65], s[5 * 65]); o.w = cvt_pk_bf16(s[6 * 65], s[7 * 65]);
        *(u32x4*)(WT + (size_t)dest_row(kind, n0 + nl) * K + k0 + 8 * c) = o; }
    asm volatile("s_waitcnt lgkmcnt(0)" ::: "memory");
}
__device__ __forceinline__ void cvt_item8(const float* W, int K, int N, unsigned char* WT, int kind, LAS float* scr, int item, int lane, float f8s) {
    const int nkb = K / 32, nb = item / nkb, kb = item - nb * nkb, k0 = kb * 32, n0 = nb * 64;
    const float* src = W + (size_t)(k0 + (lane >> 4)) * N + n0 + (lane & 15) * 4;
    f32x4 v[8];
#pragma unroll
    for (int it = 0; it < 8; ++it) v[it] = *(const f32x4*)(src + (size_t)it * 4 * N);
#pragma unroll
    for (int it = 0; it < 8; ++it) { LAS float* d = scr + (it * 4 + (lane >> 4)) * 65 + (lane & 15) * 4; d[0] = v[it][0]; d[1] = v[it][1]; d[2] = v[it][2]; d[3] = v[it][3]; }
    asm volatile("s_waitcnt lgkmcnt(0)" ::: "memory");
    const int c = lane & 3;
#pragma unroll
    for (int it = 0; it < 4; ++it) { const int nl = it * 16 + (lane >> 2); const LAS float* s = scr + (8 * c) * 65 + nl;
        u32x2 o; o.x = pk4_f8(s[0] * f8s, s[65] * f8s, s[2 * 65] * f8s, s[3 * 65] * f8s); o.y = pk4_f8(s[4 * 65] * f8s, s[5 * 65] * f8s, s[6 * 65] * f8s, s[7 * 65] * f8s);
        *(u32x2*)(WT + (size_t)dest_row(kind, n0 + nl) * K + k0 + 8 * c) = o; }
    asm volatile("s_waitcnt lgkmcnt(0)" ::: "memory");
}
__device__ __forceinline__ void p0_prologue(Ctx& F) {
    unsigned char* ws = F.ws;
    __syncthreads();
    {
        LAS float* sc = (LAS float*)F.lds;
        LAS float* red = (LAS float*)(F.lds + 5 * D * 4);
        const float* c = F.in[1]; const float* c_ctx = F.in[3]; const float* w_mod = F.in[4]; const float* b_mod = F.in[5]; float* mod = (float*)(ws + WS_MOD);
        if (F.wg < 192) {
            for (int i = F.tid; i < 5 * D; i += 512) { const int cd = i >> 10, k = i & 1023; const float v = cd < 4 ? c[cd * D + k] : c_ctx[k]; sc[i] = v * __builtin_amdgcn_rcpf(1.f + __expf(-v)); }
            __syncthreads();
            const int l = F.wg / 96, n0 = (F.wg % 96) * 64, kq = F.tid >> 4, c4 = (F.tid & 15) * 4;
            const float* w = w_mod + (size_t)l * D * 6 * D + n0 + c4;
            f32x4 a[5];
#pragma unroll
            for (int cd = 0; cd < 5; ++cd) a[cd] = (f32x4){0.f, 0.f, 0.f, 0.f};
#pragma unroll 4
            for (int i = 0; i < 32; ++i) { const int k = kq + 32 * i; const f32x4 wv = *(const f32x4*)(w + (size_t)k * 6 * D);
#pragma unroll
                for (int cd = 0; cd < 5; ++cd) a[cd] += wv * sc[cd * D + k]; }
#pragma unroll
            for (int cd = 0; cd < 5; ++cd) *(LAS f32x4*)(red + (kq * 5 + cd) * 64 + c4) = a[cd];
            __syncthreads();
            if (F.tid < 320) { const int cd = F.tid >> 6, n = F.tid & 63; float s = 0.f;
#pragma unroll 8
                for (int q = 0; q < 32; ++q) s += red[(q * 5 + cd) * 64 + n];
                mod[((size_t)l * 5 + cd) * 6 * D + n0 + n] = s + b_mod[l * 6 * D + n0 + n]; }
            __syncthreads();
        }
    }
    {
        const float* a_ws = F.in[12]; const float* wp = F.in[14]; bf16_t* awsb = (bf16_t*)(ws + WS_AWS); bf16_t* wpt = (bf16_t*)(ws + WS_WPOOL);
        const int gt = F.wg * 512 + F.tid, NT = F.G * 512;
        for (int i = gt; i < 2 * 4 * 128 * 128 / 2; i += NT) { const f32x2 v = *(const f32x2*)(a_ws + 2 * i); *(unsigned*)(awsb + 2 * i) = cvt_pk_bf16(v.x, v.y); }
        for (int i = gt; i < 2 * 4 * 64 * 64; i += NT) { const int d = i & 63, e = (i >> 6) & 63, lg = i >> 12; wpt[i] = (bf16_t)(cvt_pk_bf16(wp[((size_t)lg * 64 + d) * 64 + e], 0.f) & 0xffffu); }
    }
    {
        LAS float* scr = (LAS float*)(F.lds + F.wave * (32 * 65 * 4));
        const int gw = F.wg * NWAVES + F.wave, NGW = F.G * NWAVES;
        constexpr int I_IN = (D / 32) * (INC / 64), I_OUT = (D / 32) * (D / 64), I_FG = (D / 32) * (DFF / 64), I_FD = (DFF / 32) * (D / 64), I_MG = (D / 32) * (DFE / 64), I_MD = (DFE / 32) * (D / 64);
        constexpr int T0 = 2 * I_IN, T1 = T0 + 2 * I_OUT, T2 = T1 + 2 * I_FG, T3 = T2 + I_FD, T4 = T3 + 2 * NE * I_MG, T5 = T4 + NE * I_MD;
        for (int it = gw; it < T5; it += NGW) {
            if (it < T0) { const int l = it / I_IN; cvt_item(F.in[8] + (size_t)l * D * INC, D, INC, (bf16_t*)(ws + WS_WIN) + (size_t)l * INC * D, 1, scr, it - l * I_IN, F.lane); }
            else if (it < T1) { const int r = it - T0, l = r / I_OUT; cvt_item(F.in[9] + (size_t)l * D * D, D, D, (bf16_t*)(ws + WS_WOUT) + (size_t)l * D * D, 0, scr, r - l * I_OUT, F.lane); }
            else if (it < T2) { const int r = it - T1, w = r / I_FG; cvt_item(w ? F.in[20] : F.in[19], D, DFF, (bf16_t*)(ws + WS_WGU), 2 + w, scr, r - w * I_FG, F.lane); }
            else if (it < T3) { cvt_item(F.in[21], DFF, D, (bf16_t*)(ws + WS_WD), 0, scr, it - T2, F.lane); }
            else if (it < T4) { const int r = it - T3, m = r / I_MG, w = m / NE, e = m - w * NE;
                cvt_item8((w ? F.in[24] : F.in[23]) + (size_t)e * D * DFE, D, DFE, ws + WS_MGU + (size_t)e * 2 * DFE * D, 2 + w, scr, r - m * I_MG, F.lane, F8_WGU); }
            else { const int r = it - T4, e = r / I_MD; cvt_item8(F.in[25] + (size_t)e * DFE * D, DFE, D, ws + WS_MD + (size_t)e * D * DFE, 0, scr, r - e * I_MD, F.lane, F8_WD); }
        }
    }
}

template <bool ROUTE>
__device__ __forceinline__ void norm_phase(Ctx& F, const float* xl, const float* xc, const float* g, const float* modl, int shi, int sci, bf16_t* Hb, int nrows, const float* wr) {
    const int rpw = (nrows + F.G - 1) / F.G;
    LAS int* lcnt = (LAS int*)F.lds;
    if (ROUTE) { if (F.tid < 8) lcnt[F.tid] = 0; __syncthreads(); }
    f32x4 wreg[4][4][2];
    if (ROUTE) {
#pragma unroll
        for (int j = 0; j < 4; ++j)
#pragma unroll
            for (int q = 0; q < 4; ++q) { const int k = 256 * j + 4 * F.lane + q; wreg[j][q][0] = *(const f32x4*)(wr + k * 8); wreg[j][q][1] = *(const f32x4*)(wr + k * 8 + 4); }
    }
    for (int i = F.wave; i < rpw; i += NWAVES) {
        const int row = F.wg * rpw + i; if (row >= nrows) break;
        const float* x = row < NLAT ? xl + (size_t)row * D : xc + (size_t)(row - NLAT) * D;
        const int cd = row < NLAT ? row / SEQ : 4;
        const float* sh = modl + ((size_t)cd * 6 + shi) * D; const float* sc = modl + ((size_t)cd * 6 + sci) * D;
        f32x4 v[4]; float s = 0.f;
#pragma unroll
        for (int j = 0; j < 4; ++j) { v[j] = *(const f32x4*)(x + 256 * j + 4 * F.lane); s += (v[j][0] * v[j][0] + v[j][1] * v[j][1]) + (v[j][2] * v[j][2] + v[j][3] * v[j][3]); }
        const float rs = __builtin_amdgcn_rsqf(wave_sum(s) * (1.0f / D) + EPS);
#pragma unroll
        for (int j = 0; j < 4; ++j) { const int c = 256 * j + 4 * F.lane; const f32x4 gg = *(const f32x4*)(g + c), s1 = *(const f32x4*)(sc + c), s0 = *(const f32x4*)(sh + c);
            v[j] = v[j] * rs * gg * (s1 + 1.0f) + s0;
            if (ROUTE) *(unsigned*)((unsigned char*)Hb + (size_t)row * D + c) = pk4_f8(v[j][0] * F8_ACT, v[j][1] * F8_ACT, v[j][2] * F8_ACT, v[j][3] * F8_ACT);
            else { u32x2 w; w.x = cvt_pk_bf16(v[j][0], v[j][1]); w.y = cvt_pk_bf16(v[j][2], v[j][3]); *(u32x2*)(Hb + (size_t)row * D + c) = w; } }
        if (ROUTE) {
            float a[8];
#pragma unroll
            for (int e = 0; e < 8; ++e) a[e] = 0.f;
#pragma unroll
            for (int j = 0; j < 4; ++j)
#pragma unroll
                for (int q = 0; q < 4; ++q) { const float hv = v[j][q]; const f32x4 w0 = wreg[j][q][0], w1 = wreg[j][q][1];
                    a[0] += hv * w0[0]; a[1] += hv * w0[1]; a[2] += hv * w0[2]; a[3] += hv * w0[3]; a[4] += hv * w1[0]; a[5] += hv * w1[1]; a[6] += hv * w1[2]; a[7] += hv * w1[3]; }
            float b4[4], c2[2], dsum;
            { const bool hi = (F.lane & 32) != 0;
#pragma unroll
              for (int i = 0; i < 4; ++i) { const float keep = hi ? a[4 + i] : a[i], send = hi ? a[i] : a[4 + i]; b4[i] = keep + __shfl_xor(send, 32); } }
            { const bool hi = (F.lane & 16) != 0;
#pragma unroll
              for (int i = 0; i < 2; ++i) { const float keep = hi ? b4[2 + i] : b4[i], send = hi ? b4[i] : b4[2 + i]; c2[i] = keep + __shfl_xor(send, 16); } }
            { const bool hi = (F.lane & 8) != 0; const float keep = hi ? c2[1] : c2[0], send = hi ? c2[0] : c2[1]; dsum = keep + __shfl_xor(send, 8); }
            dsum += __shfl_xor(dsum, 4); dsum += __shfl_xor(dsum, 2); dsum += __shfl_xor(dsum, 1);
#pragma unroll
            for (int e = 0; e < 8; ++e) a[e] = __uint_as_float(__builtin_amdgcn_readlane(__float_as_uint(dsum), 8 * e));
            int i0 = 0; float v0 = a[0];
#pragma unroll
            for (int e = 1; e < 8; ++e) if (a[e] > v0) { v0 = a[e]; i0 = e; }
            int i1 = -1; float v1 = -3.0e38f;
#pragma unroll
            for (int e = 0; e < 8; ++e) if (e != i0 && a[e] > v1) { v1 = a[e]; i1 = e; }
            if (F.lane == 0) { const float p1 = __expf(v1 - v0); const float g0 = 1.f / (1.f + p1);
                int* e01 = (int*)(F.ws + WS_E01); float* g01 = (float*)(F.ws + WS_G01);
                e01[row * 2] = i0; e01[row * 2 + 1] = i1; g01[row * 2] = g0; g01[row * 2 + 1] = p1 * g0;
                __hip_atomic_fetch_add(lcnt + i0, 1, __ATOMIC_RELAXED, __HIP_MEMORY_SCOPE_WORKGROUP); __hip_atomic_fetch_add(lcnt + i1, 1, __ATOMIC_RELAXED, __HIP_MEMORY_SCOPE_WORKGROUP); }
        }
    }
    if (ROUTE) { __syncthreads(); if (F.tid < 8) ((int*)(F.ws + WS_CNTW))[F.wg * 8 + F.tid] = lcnt[F.tid]; __syncthreads(); }
}

__device__ __forceinline__ void lists_phase(Ctx& F) {
    LAS int* tab = (LAS int*)F.lds;
    LAS int* offw = tab + 256 * 8;
    LAS int* tot = offw + 8;
    LAS int* pb = tot + 8;
    const int* cntw = (const int*)(F.ws + WS_CNTW);
    for (int i = F.tid; i < F.G * 8; i += 512) tab[i] = cntw[i];
    __syncthreads();
    if (F.tid < 8) { int o = 0, t = 0; for (int w = 0; w < F.G; ++w) { const int c = tab[w * 8 + F.tid]; if (w < F.wg) o += c; t += c; } offw[F.tid] = o; tot[F.tid] = t; }
    __syncthreads();
    if (F.tid == 0) { int p = 0; for (int e = 0; e < 8; ++e) { pb[e] = p; p += (tot[e] + 255) >> 8; } pb[8] = p; }
    __syncthreads();
    int* list = (int*)(F.ws + WS_LIST); float* lgate = (float*)(F.ws + WS_LGATE); int* pexp = (int*)(F.ws + WS_PEXP);
    if (F.wave == 0) {
        const int tok = F.wg * 64 + F.lane; const int* e01 = (const int*)(F.ws + WS_E01); const float* g01 = (const float*)(F.ws + WS_G01);
        const int e0 = e01[tok * 2], e1 = e01[tok * 2 + 1]; const float g0 = g01[tok * 2], g1 = g01[tok * 2 + 1];
#pragma unroll
        for (int e = 0; e < 8; ++e) { const bool f = (e0 == e) || (e1 == e); const unsigned long long bal = __ballot(f);
            if (f) { const int rank = __popcll(bal & ((1ull << F.lane) - 1ull)); const int pos = pb[e] * 256 + offw[e] + rank; const int slot = (e0 == e) ? 0 : 1;
                list[pos] = tok * 2 + slot; lgate[pos] = slot ? g1 : g0; } }
    }
    if (F.wg == 0) {
        for (int e = 0; e < 8; ++e) { const int n = tot[e], base = pb[e] * 256, end = (pb[e + 1]) * 256; for (int i = base + n + F.tid; i < end; i += 512) { list[i] = -1; lgate[i] = 0.f; } }
        for (int p = F.tid; p < MAXP; p += 512) { int e = 0;
#pragma unroll
            for (int q = 1; q < 8; ++q) if (p >= pb[q]) e = q;
            pexp[p] = e; }
        if (F.tid == 0) pexp[MAXP] = pb[8];
    }
    __syncthreads();
}

__device__ __forceinline__ s16x4 vtr(const LAS unsigned char* p) { typedef short v4i16_t __attribute__((ext_vector_type(4))); return __builtin_bit_cast(s16x4, __builtin_amdgcn_ds_read_tr16_b64_v4i16((LAS v4i16_t*)p)); }
__device__ __forceinline__ bf16x8 pack8(const f32x4 a, const f32x4 b) {
    u32x4 w; w.x = cvt_pk_bf16(a[0], a[1]); w.y = cvt_pk_bf16(a[2], a[3]); w.z = cvt_pk_bf16(b[0], b[1]); w.w = cvt_pk_bf16(b[2], b[3]); return __builtin_bit_cast(bf16x8, w);
}
__device__ __forceinline__ bf16x8 cat4(const s16x4 a, const s16x4 b) { return (bf16x8){a[0], a[1], a[2], a[3], b[0], b[1], b[2], b[3]}; }

template <int NQB, bool LOCAL>
__device__ __forceinline__ void attn_unit(Ctx& F, const bf16_t* P, bf16_t* MIX, const float* rpbh, int b, int h, int qrow0, int r, int jlo, int jhi) {
    LAS unsigned char* lds = F.lds; const int tid = F.tid, lane = F.lane, fr = lane & 15, fq = lane >> 4;
    LAS float* btab = (LAS float*)(lds + 32768);
    if (LOCAL) { for (int i = tid; i < 15 * 64; i += 512) { const int idx = (i & 63) - 16; btab[i] = (idx >= 0 && idx <= 30) ? rpbh[(i >> 6) * 31 + idx] : 0.f; } }
    unsigned wmask = 0u;
    if (LOCAL) {
#pragma unroll
        for (int qb = 0; qb < NQB; ++qb) { const int cw = qb == 0 ? 0 : (qb == 1 ? 8 : (qb == 2 ? 24 : 32)); const int qc = 16 * qb + fr; int cs = qc - 8; cs = cs < 0 ? 0 : (cs > 48 ? 48 : cs);
#pragma unroll
            for (int kb = 0; kb < 2; ++kb)
#pragma unroll
                for (int q = 0; q < 4; ++q) { const int kc = cw + 16 * kb + 4 * fq + q; if (kc >= cs && kc < cs + 16) wmask |= 1u << (qb * 8 + kb * 4 + q); } }
    }
    bf16x8 qf[NQB][2];
#pragma unroll
    for (int qb = 0; qb < NQB; ++qb)
#pragma unroll
        for (int ks = 0; ks < 2; ++ks) qf[qb][ks] = *(const bf16x8*)(P + (size_t)(qrow0 + qb * 16 + fr) * INC + OFF_Q + h * 64 + 8 * fq + 32 * ks);
    f32x4 o[NQB][4]; float mrun[NQB], lrun[NQB];
#pragma unroll
    for (int qb = 0; qb < NQB; ++qb) { mrun[qb] = -1.0e30f; lrun[qb] = 0.f;
#pragma unroll
        for (int db = 0; db < 4; ++db) o[qb][db] = (f32x4){0.f, 0.f, 0.f, 0.f}; }
    const int trow = tid >> 3, pc = tid & 7, lcK = pc ^ (trow & 7), lcV = pc ^ (((trow >> 1) & 3) << 1);
    const int T = 4 + (LOCAL ? (jhi - jlo) : 0);
    u32x4 kreg, vreg;
    { const size_t tok = (size_t)NLAT + b * CTX + trow; kreg = *(const u32x4*)(P + tok * INC + OFF_K + h * 64 + lcK * 8); vreg = *(const u32x4*)(P + tok * INC + OFF_VV + h * 64 + lcV * 8); }
    const int kaddr0 = fr * 128 + (((fq) ^ (fr & 7)) * 16), kaddr1 = fr * 128 + (((fq + 4) ^ (fr & 7)) * 16);
    const int vq = (lane & 15) >> 2, vp = lane & 3, vrow = 4 * fq + vq, vsw = ((vrow & 7) >> 1) << 1;
    for (int t = 0; t < T; ++t) {
        LAS unsigned char* slot = lds + (t & 1) * 16384;
        *(LAS u32x4*)(slot + tid * 16) = kreg; *(LAS u32x4*)(slot + 8192 + tid * 16) = vreg;
        if (t + 1 < T) { const int tn = t + 1; const size_t tok = tn < 4 ? (size_t)NLAT + b * CTX + tn * 64 + trow : (size_t)b * SEQ + (jlo + tn - 4) * 64 + trow;
            kreg = *(const u32x4*)(P + tok * INC + OFF_K + h * 64 + lcK * 8); vreg = *(const u32x4*)(P + tok * INC + OFF_VV + h * 64 + lcV * 8); }
        __syncthreads();
        const LAS unsigned char* Ks = slot; const LAS unsigned char* Vs = slot + 8192;
        if (t < 4) {
#pragma unroll
            for (int qb = 0; qb < NQB; ++qb) {
                f32x4 s[4];
#pragma unroll
                for (int kb = 0; kb < 4; ++kb) { s[kb] = __builtin_amdgcn_mfma_f32_16x16x32_bf16(*(const LAS bf16x8*)(Ks + kb * 2048 + kaddr0), qf[qb][0], (f32x4){0.f, 0.f, 0.f, 0.f}, 0, 0, 0);
                    s[kb] = __builtin_amdgcn_mfma_f32_16x16x32_bf16(*(const LAS bf16x8*)(Ks + kb * 2048 + kaddr1), qf[qb][1], s[kb], 0, 0, 0); }
                float tm = -1.0e30f;
#pragma unroll
                for (int kb = 0; kb < 4; ++kb) tm = fmaxf(fmaxf(tm, fmaxf(s[kb][0], s[kb][1])), fmaxf(s[kb][2], s[kb][3]));
                tm = fmaxf(tm, __shfl_xor(tm, 16)); tm = fmaxf(tm, __shfl_xor(tm, 32));
                const float mn = fmaxf(mrun[qb], tm), al = __builtin_amdgcn_exp2f((mrun[qb] - mn) * L2E), mb = mn * L2E; mrun[qb] = mn;
                float ps = 0.f;
#pragma unroll
                for (int kb = 0; kb < 4; ++kb)
#pragma unroll
                    for (int q = 0; q < 4; ++q) { const float p = __builtin_amdgcn_exp2f(s[kb][q] * L2E - mb); s[kb][q] = p; ps += p; }
                lrun[qb] = lrun[qb] * al + ps;
                const bf16x8 p0 = pack8(s[0], s[1]), p1 = pack8(s[2], s[3]);
#pragma unroll
                for (int db = 0; db < 4; ++db) { const int ca = (((2 * db + (vp >> 1)) ^ vsw) * 16) + (vp & 1) * 8;
                    const bf16x8 vf0 = cat4(vtr(Vs + vrow * 128 + ca), vtr(Vs + (16 + vrow) * 128 + ca)), vf1 = cat4(vtr(Vs + (32 + vrow) * 128 + ca), vtr(Vs + (48 + vrow) * 128 + ca));
                    o[qb][db] = o[qb][db] * al;
                    o[qb][db] = __builtin_amdgcn_mfma_f32_16x16x32_bf16(vf0, p0, o[qb][db], 0, 0, 0);
                    o[qb][db] = __builtin_amdgcn_mfma_f32_16x16x32_bf16(vf1, p1, o[qb][db], 0, 0, 0); }
                __builtin_amdgcn_sched_barrier(0);
            }
        } else if (LOCAL) {
            const int j = jlo + t - 4; int rs = r - 4; rs = rs < 0 ? 0 : (rs > 56 ? 56 : rs);
            if (j >= rs && j < rs + 8) {
                const LAS float* brow = btab + (j - r + 7) * 64 + (4 * fq - fr);
#pragma unroll
                for (int qb = 0; qb < NQB; ++qb) {
                    const int cw = qb == 0 ? 0 : (qb == 1 ? 8 : (qb == 2 ? 24 : 32));
                    f32x4 s[2];
#pragma unroll
                    for (int kb = 0; kb < 2; ++kb) { const LAS unsigned char* kp = Ks + (cw + 16 * kb) * 128;
                        s[kb] = __builtin_amdgcn_mfma_f32_16x16x32_bf16(*(const LAS bf16x8*)(kp + kaddr0), qf[qb][0], (f32x4){0.f, 0.f, 0.f, 0.f}, 0, 0, 0);
                        s[kb] = __builtin_amdgcn_mfma_f32_16x16x32_bf16(*(const LAS bf16x8*)(kp + kaddr1), qf[qb][1], s[kb], 0, 0, 0); }
                    float tm = -1.0e30f;
#pragma unroll
                    for (int kb = 0; kb < 2; ++kb)
#pragma unroll
                        for (int q = 0; q < 4; ++q) { const bool inw = (wmask >> (qb * 8 + kb * 4 + q)) & 1u;
                            const float sv = inw ? s[kb][q] + brow[31 + cw + 16 * kb + q - 16 * qb] : -1.0e30f; s[kb][q] = sv; tm = fmaxf(tm, sv); }
                    tm = fmaxf(tm, __shfl_xor(tm, 16)); tm = fmaxf(tm, __shfl_xor(tm, 32));
                    const float mn = fmaxf(mrun[qb], tm), al = __builtin_amdgcn_exp2f((mrun[qb] - mn) * L2E), mb = mn * L2E; mrun[qb] = mn;
                    float ps = 0.f;
#pragma unroll
                    for (int kb = 0; kb < 2; ++kb)
#pragma unroll
                        for (int q = 0; q < 4; ++q) { const float p = __builtin_amdgcn_exp2f(s[kb][q] * L2E - mb); s[kb][q] = p; ps += p; }
                    lrun[qb] = lrun[qb] * al + ps;
                    const bf16x8 p0 = pack8(s[0], s[1]);
#pragma unroll
                    for (int db = 0; db < 4; ++db) { const int ca = (((2 * db + (vp >> 1)) ^ vsw) * 16) + (vp & 1) * 8;
                        const bf16x8 vfr = cat4(vtr(Vs + (cw + vrow) * 128 + ca), vtr(Vs + (cw + 16 + vrow) * 128 + ca));
                        o[qb][db] = o[qb][db] * al;
                        o[qb][db] = __builtin_amdgcn_mfma_f32_16x16x32_bf16(vfr, p0, o[qb][db], 0, 0, 0); }
                    __builtin_amdgcn_sched_barrier(0);
                }
            }
        }
    }
#pragma unroll
    for (int qb = 0; qb < NQB; ++qb) { float l = lrun[qb]; l += __shfl_xor(l, 16); l += __shfl_xor(l, 32); const float inv = 1.0f / l;
        bf16_t* dst = MIX + (size_t)(qrow0 + qb * 16 + fr) * D + 512 + h * 64 + 4 * fq;
#pragma unroll
        for (int db = 0; db < 4; ++db) { const f32x4 v = o[qb][db] * inv; u32x2 w; w.x = cvt_pk_bf16(v[0], v[1]); w.y = cvt_pk_bf16(v[2], v[3]); *(u32x2*)(dst + 16 * db) = w; } }
    __syncthreads();
}

__device__ __forceinline__ void chunk_unit(Ctx& F, const bf16_t* P, bf16_t* MIX, const bf16_t* awsb, const float* a_bs, const float* vn_g, const float* vn_b,
                                           const bf16_t* wpt, const float* b_scale, int c0, int s0, int n) {
    LAS unsigned char* lds = F.lds; const int tid = F.tid, lane = F.lane, fr = lane & 15, fq = lane >> 4, w = F.wave;
    constexpr int VP = 272;
    {
        const int pos = tid >> 2, qt = tid & 3; const bf16_t* src = P + (size_t)(c0 + pos) * INC + OFF_V + qt * 64;
        float x[64]; float s = 0.f;
#pragma unroll
        for (int i = 0; i < 8; ++i) { float f[8]; unpack8(*(const u32x4*)(src + 8 * i), f);
#pragma unroll
            for (int q = 0; q < 8; ++q) { x[8 * i + q] = f[q]; s += f[q]; } }
        s += __shfl_xor(s, 1); s += __shfl_xor(s, 2);
        const float mean = s * (1.0f / 256.0f); float ss = 0.f;
#pragma unroll
        for (int i = 0; i < 64; ++i) { x[i] -= mean; ss += x[i] * x[i]; }
        ss += __shfl_xor(ss, 1); ss += __shfl_xor(ss, 2);
        const float rstd = __builtin_amdgcn_rsqf(ss * (1.0f / 256.0f) + EPS);
#pragma unroll
        for (int i = 0; i < 64; ++i) { const int ch = qt * 64 + i; const float y = x[i] * rstd * vn_g[ch] + vn_b[ch];
            *(LAS bf16_t*)(lds + ch * VP + pos * 2) = (bf16_t)(cvt_pk_bf16(y, 0.f) & 0xffffu); }
    }
    __syncthreads();
    {
        const int g = w >> 1, ih = w & 1;
        bf16x8 af[4][4];
#pragma unroll
        for (int cb = 0; cb < 4; ++cb)
#pragma unroll
            for (int ks = 0; ks < 4; ++ks) af[cb][ks] = *(const LAS bf16x8*)(lds + (g * 64 + cb * 16 + fr) * VP + (8 * fq + 32 * ks) * 2);
#pragma unroll
        for (int ib = 0; ib < 4; ++ib) { const int i0 = ih * 64 + ib * 16;
            bf16x8 bw[4];
#pragma unroll
            for (int ks = 0; ks < 4; ++ks) bw[ks] = *(const bf16x8*)(awsb + ((size_t)(g * 128 + i0 + fr) * 128 + 8 * fq + 32 * ks));
            const float bsv = a_bs[g * 128 + i0 + fr];
#pragma unroll
            for (int cb = 0; cb < 4; ++cb) { f32x4 acc = (f32x4){0.f, 0.f, 0.f, 0.f};
#pragma unroll
                for (int ks = 0; ks < 4; ++ks) acc = __builtin_amdgcn_mfma_f32_16x16x32_bf16(af[cb][ks], bw[ks], acc, 0, 0, 0);
                const int ch = g * 64 + cb * 16 + 4 * fq; const size_t row = (size_t)(c0 + i0 + fr);
                const u32x2 uu = *(const u32x2*)(P + row * INC + OFF_U + ch);
                const float u0 = __uint_as_float(uu.x << 16), u1 = __uint_as_float(uu.x & 0xffff0000u), u2 = __uint_as_float(uu.y << 16), u3 = __uint_as_float(uu.y & 0xffff0000u);
                u32x2 o; o.x = cvt_pk_bf16(u0 * (acc[0] + bsv), u1 * (acc[1] + bsv)); o.y = cvt_pk_bf16(u2 * (acc[2] + bsv), u3 * (acc[3] + bsv));
                *(u32x2*)(MIX + row * D + ch) = o; } }
    }
    __syncthreads();
    constexpr int ZP = 528;
    for (int i = tid; i < 145 * 32; i += 512) { const int zr = i >> 5, ck = i & 31; const int row = c0 - 8 + zr;
        if (row >= s0 && row < s0 + n) *(LAS u32x4*)(lds + zr * ZP + ck * 16) = *(const u32x4*)(P + (size_t)row * INC + OFF_Z + ck * 8); }
    __syncthreads();
    {
        const int t = c0 + 16 * w + fr, pos = t - s0, zr0 = 16 * w + fr + 8;
#pragma unroll
        for (int g = 0; g < 4; ++g) { const int half = 1 << g;
            int lo = pos - half; lo = lo < 0 ? 0 : lo; int hi = pos + half; hi = hi > n ? n : hi; const float icnt = 1.0f / (float)(hi - lo);
            f32x4 acc[4];
#pragma unroll
            for (int eb = 0; eb < 4; ++eb) acc[eb] = (f32x4){0.f, 0.f, 0.f, 0.f};
#pragma unroll
            for (int ks = 0; ks < 2; ++ks) { const int ch0 = g * 64 + ks * 32 + 8 * fq; float sum[8];
#pragma unroll
                for (int q = 0; q < 8; ++q) sum[q] = 0.f;
#pragma unroll
                for (int dt = -half; dt < half; ++dt) { const int pp = pos + dt; const bool ok = pp >= 0 && pp < n; float f[8]; unpack8(*(const LAS u32x4*)(lds + (zr0 + dt) * ZP + ch0 * 2), f);
#pragma unroll
                    for (int q = 0; q < 8; ++q) sum[q] += ok ? f[q] : 0.f; }
                float zc[8]; unpack8(*(const LAS u32x4*)(lds + zr0 * ZP + ch0 * 2), zc);
                f32x4 ya, yb; ya[0] = sum[0] * icnt - zc[0]; ya[1] = sum[1] * icnt - zc[1]; ya[2] = sum[2] * icnt - zc[2]; ya[3] = sum[3] * icnt - zc[3];
                yb[0] = sum[4] * icnt - zc[4]; yb[1] = sum[5] * icnt - zc[5]; yb[2] = sum[6] * icnt - zc[6]; yb[3] = sum[7] * icnt - zc[7];
                const bf16x8 yf = pack8(ya, yb);
#pragma unroll
                for (int eb = 0; eb < 4; ++eb) { const bf16x8 wf = *(const bf16x8*)(wpt + ((size_t)(g * 64 + eb * 16 + fr) * 64 + ks * 32 + 8 * fq));
                    acc[eb] = __builtin_amdgcn_mfma_f32_16x16x32_bf16(wf, yf, acc[eb], 0, 0, 0); } }
#pragma unroll
            for (int eb = 0; eb < 4; ++eb) { const int e0 = g * 64 + eb * 16 + 4 * fq; const f32x4 sc = *(const f32x4*)(b_scale + e0); const f32x4 v = acc[eb] * sc;
                u32x2 o; o.x = cvt_pk_bf16(v[0], v[1]); o.y = cvt_pk_bf16(v[2], v[3]); *(u32x2*)(MIX + (size_t)t * D + 256 + e0) = o; } }
    }
    __syncthreads();
}

template <int L>
__device__ __forceinline__ void mixer_phase(Ctx& F) {
    const bf16_t* P = (const bf16_t*)(F.ws + WS_PROJ); bf16_t* MIX = (bf16_t*)(F.ws + WS_MIX);
#ifndef MIX_NO_ATTN
#ifdef MIXDUP_ATTN
    for (int rep = 0; rep < 2; ++rep)
#endif
    for (int u = F.wg; u < 256; u += F.G) {
        const int b = u >> 6, h = (u >> 3) & 7, R0 = (u & 7) * 8, r = R0 + F.wave;
        int jlo = R0 - 4; jlo = jlo < 0 ? 0 : (jlo > 56 ? 56 : jlo); int jhi = R0 + 3; jhi = (jhi < 0 ? 0 : (jhi > 56 ? 56 : jhi)) + 8;
        attn_unit<4, true>(F, P, MIX, F.in[18] + ((size_t)L * NH + h) * 15 * 31, b, h, b * SEQ + r * 64, r, jlo, jhi);
    }
#endif
    const int nchunk = (L == DEPTH - 1 ? NLAT : R) / 128;
    const bf16_t* awsb = (const bf16_t*)(F.ws + WS_AWS) + (size_t)L * 4 * 128 * 128; const bf16_t* wpt = (const bf16_t*)(F.ws + WS_WPOOL) + (size_t)L * 4 * 64 * 64;
#ifndef MIX_NO_CHUNK
#ifdef MIXDUP_CHUNK
    for (int rep = 0; rep < 2; ++rep)
#endif
    for (int u = F.wg; u < nchunk; u += F.G) {
        const int c0 = u * 128; int s0, n; if (c0 < NLAT) { s0 = (c0 / SEQ) * SEQ; n = SEQ; } else { s0 = NLAT + ((c0 - NLAT) / CTX) * CTX; n = CTX; }
        chunk_unit(F, P, MIX, awsb, F.in[13] + L * 4 * 128, F.in[10] + L * 256, F.in[11] + L * 256, wpt, F.in[15] + L * 256, c0, s0, n);
    }
#endif
#ifndef MIX_NO_CATTN
    if (L != DEPTH - 1) {
        for (int u = F.wg - nchunk % F.G; u < 64; u += F.G) { if (u < 0) continue;
            const int b = u >> 4, h = (u >> 1) & 7, half = u & 1;
            attn_unit<1, false>(F, P, MIX, nullptr, b, h, NLAT + b * CTX + half * 128 + F.wave * 16, 0, 0, 0);
        }
    }
#endif
}

__device__ __forceinline__ void combine_phase(Ctx& F, const float* modl) {
    const bf16_t* Y = (const bf16_t*)(F.ws + WS_Y); float* out = F.out;
    const int gw = F.wg * NWAVES + F.wave, NGW = F.G * NWAVES;
    for (int row = gw; row < NLAT; row += NGW) { const int cd = row / SEQ; const float* ga = modl + ((size_t)cd * 6 + 5) * D;
#pragma unroll
        for (int j = 0; j < 2; ++j) { const int c = 512 * j + 8 * F.lane; float a[8], bb[8];
            unpack8(*(const u32x4*)(Y + (size_t)row * D + c), a); unpack8(*(const u32x4*)(Y + ((size_t)NLAT + row) * D + c), bb);
            const f32x4 g0 = *(const f32x4*)(ga + c), g1 = *(const f32x4*)(ga + c + 4); float* o = out + (size_t)row * D + c;
            f32x4 x0 = *(const f32x4*)o, x1 = *(const f32x4*)(o + 4);
            x0[0] += g0[0] * (a[0] + bb[0]); x0[1] += g0[1] * (a[1] + bb[1]); x0[2] += g0[2] * (a[2] + bb[2]); x0[3] += g0[3] * (a[3] + bb[3]);
            x1[0] += g1[0] * (a[4] + bb[4]); x1[1] += g1[1] * (a[5] + bb[5]); x1[2] += g1[2] * (a[6] + bb[6]); x1[3] += g1[3] * (a[7] + bb[7]);
            *(f32x4*)o = x0; *(f32x4*)(o + 4) = x1; } }
}

#ifndef MK_PER_PHASE
#define MK_PER_PHASE 0
#endif
constexpr int NPHASE = 17;
__global__ void __launch_bounds__(NWAVES * 64, 2) mk_fwd(Args args) {
    extern __shared__ __attribute__((aligned(16))) unsigned char lds_raw[];
    Ctx F; F.lds = (LAS unsigned char*)lds_raw; F.tid = threadIdx.x; F.lane = F.tid & 63; F.wave = __builtin_amdgcn_readfirstlane(F.tid >> 6); F.G = gridDim.x; F.wg = blockIdx.x;
    F.ws = args.ws; F.in = args.in; F.out = args.out;
    volatile LAS unsigned* MISC = (volatile LAS unsigned*)(F.lds + LDSCTL_OFF);
    for (int u = F.tid; u < 256; u += NWAVES * 64) MISC[u] = 0u;
    __syncthreads();
    XcdBarrier bar; bar.bar = (unsigned*)(args.ws + WS_CTL); bar.x = 0; bar.st = nullptr;
    if (!MK_PER_PHASE) bar = xcd_barrier_post((unsigned*)(args.ws + WS_CTL), MISC + 8);
    const int lo = args.ph_lo, hi = args.ph_hi;
#ifndef PHASE_MASK
#define PHASE_MASK 0x1ffff
#endif
#define IN(k) ((((PHASE_MASK) >> (k)) & 1) && lo <= (k) && (k) < hi)
#define SEAM(k) do { if (IN(k) && IN((k) + 1)) xcd_barrier(bar); } while (0)
#ifndef DUP_MASK
#define DUP_MASK 0
#endif
#define PHASE(k, ...) do { if (IN(k)) { __VA_ARGS__; if constexpr ((((DUP_MASK) >> (k)) & 1) != 0) { __VA_ARGS__; } } } while (0)
    unsigned char* ws = args.ws;
    const float* mod = (const float*)(ws + WS_MOD);
    bf16_t* Hb = (bf16_t*)(ws + WS_HB); bf16_t* PROJ = (bf16_t*)(ws + WS_PROJ); bf16_t* MIX = (bf16_t*)(ws + WS_MIX);
    float* X1 = (float*)(ws + WS_X1); float* XC1 = (float*)(ws + WS_XC1); float* XMC = (float*)(ws + WS_XMC);
    LAS int* pexp_l = (LAS int*)(F.lds + LDSCTL_OFF + 256);

    typedef pg8::StreamK<pg8::DenseDec> SKD; typedef pg8::StreamK<pg8::MoeDec> SKM;
    const int skrank = (F.G % 8 == 0) ? (F.wg % 8) * (F.G / 8) + F.wg / 8 : F.wg;
#define SK_DENSE(nM_, nN_, P_, dp_) SKD S; S.init(pg8::DenseDec{(nM_), (nN_)}, (nM_) * (nN_), (P_), F.G, skrank, F.wg, (dp_))
#define SK_MOE(nN_, P_, dp_) SKM S; S.init(pg8::MoeDec{pexp_l[MAXP], (nN_), pexp_l}, pexp_l[MAXP] * (nN_), (P_), F.G, skrank, F.wg, (dp_))
#define SKC(ph) pg8::SlabCtl{ws + WS_SLAB, (unsigned*)(ws + WS_FLAG), (unsigned)(ph), (unsigned*)(ws + WS_TMO)}
    PHASE(0, p0_prologue(F));
    SEAM(0);
    {
        const float* modl = mod;
        PHASE(1, norm_phase<false>(F, F.in[0], F.in[2], F.in[6], modl, 0, 1, Hb, R, nullptr));
        SEAM(1);
        PHASE(2, { pg8::Gemm g{Hb, ws + WS_WIN, D, nullptr, 0, 0}; SK_DENSE(R / 256, INC / 256, 8, true); pg8::EpiInProj E{PROJ, F.in[16], F.in[17]}; pg8::gemm_phase<pg8::EpiInProj, SKD, false>(F.lds, g, S, E, SKC(2)); });
        SEAM(2);
        PHASE(3, mixer_phase<0>(F));
        SEAM(3);
        PHASE(4, { pg8::Gemm g{MIX, ws + WS_WOUT, D, nullptr, 0, 0}; SK_DENSE(R / 256, D / 256, 8, false); pg8::EpiResGate E{F.in[0], F.in[2], F.out, XMC, modl + 2 * D}; pg8::gemm_phase<pg8::EpiResGate, SKD, false>(F.lds, g, S, E, SKC(4)); });
        SEAM(4);
        PHASE(5, norm_phase<false>(F, F.out, XMC, F.in[7], modl, 3, 4, Hb, R, nullptr));
        SEAM(5);
        PHASE(6, { pg8::Gemm g{Hb, ws + WS_WGU, D, nullptr, 0, 0}; SK_DENSE(R / 256, 2 * DFF / 256, 8, true); pg8::EpiSwiGLU<false> E{ws + WS_HFF, DFF}; pg8::gemm_phase<pg8::EpiSwiGLU<false>, SKD, false>(F.lds, g, S, E, SKC(6)); });
        SEAM(6);
        PHASE(7, { pg8::Gemm g{ws + WS_HFF, ws + WS_WD, DFF, nullptr, 0, 0}; SK_DENSE(R / 256, D / 256, DFF / 128, false); pg8::EpiResGate E{F.out, XMC, X1, XC1, modl + 5 * D}; pg8::gemm_phase<pg8::EpiResGate, SKD, false>(F.lds, g, S, E, SKC(7)); });
        SEAM(7);
    }
    {
        const float* modl = mod + 5 * 6 * D;
        PHASE(8, norm_phase<false>(F, X1, XC1, F.in[6] + D, modl, 0, 1, Hb, R, nullptr));
        SEAM(8);
        PHASE(9, { pg8::Gemm g{Hb, ws + WS_WIN + (size_t)INC * D * 2, D, nullptr, 0, 0}; SK_DENSE(R / 256, INC / 256, 8, true); pg8::EpiInProj E{PROJ, F.in[16] + HD, F.in[17] + HD}; pg8::gemm_phase<pg8::EpiInProj, SKD, false>(F.lds, g, S, E, SKC(9)); });
        SEAM(9);
        PHASE(10, mixer_phase<1>(F));
        SEAM(10);
        PHASE(11, { pg8::Gemm g{MIX, ws + WS_WOUT + (size_t)D * D * 2, D, nullptr, 0, 0}; SK_DENSE(NLAT / 256, D / 256, 8, true); pg8::EpiResGate E{X1, nullptr, F.out, nullptr, modl + 2 * D}; pg8::gemm_phase<pg8::EpiResGate, SKD, false>(F.lds, g, S, E, SKC(11)); });
        SEAM(11);
        PHASE(12, norm_phase<true>(F, F.out, nullptr, F.in[7] + D, modl, 3, 4, (bf16_t*)(ws + WS_H8), NLAT, F.in[22]));
        SEAM(12);
        PHASE(13, lists_phase(F));
        SEAM(13);
        if (IN(14) || IN(15)) { const int* pexp = (const int*)(ws + WS_PEXP); for (int i = F.tid; i <= MAXP; i += 512) pexp_l[i] = pexp[i]; __syncthreads(); }
        PHASE(14, { pg8::Gemm g{ws + WS_H8, ws + WS_MGU, D, (const int*)(ws + WS_LIST), SC_WGU, SC_ACT}; SK_MOE(2 * DFE / 256, D / 256, true); pg8::EpiSwiGLU<true> E{ws + WS_HFM, DFE}; pg8::gemm_phase<pg8::EpiSwiGLU<true>, SKM, true, true>(F.lds, g, S, E, SKC(14)); });
        SEAM(14);
        PHASE(15, { pg8::Gemm g{ws + WS_HFM, ws + WS_MD, DFE, nullptr, SC_WD, SC_ACT}; SK_MOE(D / 256, DFE / 256, false); pg8::EpiMoeDown E{(bf16_t*)(ws + WS_Y), (const int*)(ws + WS_LIST), (const float*)(ws + WS_LGATE)}; pg8::gemm_phase<pg8::EpiMoeDown, SKM, false, true>(F.lds, g, S, E, SKC(15)); });
        SEAM(15);
        if (IN(16)) combine_phase(F, modl);
    }
#undef IN
#undef SEAM
}

extern "C" void kernel_launch(void* const* d_in, const int* in_sizes, int n_in, void* d_out, int out_size, void* d_ws, size_t ws_size, hipStream_t stream) {
    static int grid = 0;
    if (grid == 0) {
        if (n_in != 26 || in_sizes[0] != NLAT * D || out_size != NLAT * D || ws_size < WS_END) { fprintf(stderr, "kernel_launch: unexpected shapes / workspace (n_in %d, ws %zu)\n", n_in, ws_size); grid = -1; return; }
        int dev = 0, cus = 0, per_cu = 0;
        if (hipGetDevice(&dev) != hipSuccess || hipDeviceGetAttribute(&cus, hipDeviceAttributeMultiprocessorCount, dev) != hipSuccess) { grid = -1; return; }
        if (hipFuncSetAttribute((const void*)mk_fwd, hipFuncAttributeMaxDynamicSharedMemorySize, LDS_BYTES) != hipSuccess) { fprintf(stderr, "kernel_launch: hipFuncSetAttribute failed\n"); grid = -1; return; }
        if (hipOccupancyMaxActiveBlocksPerMultiprocessor(&per_cu, (const void*)mk_fwd, NWAVES * 64, LDS_BYTES) != hipSuccess || per_cu < 1) { fprintf(stderr, "kernel_launch: occupancy query says %d\n", per_cu); }
        (void)hipGetLastError();
        grid = cus;
    }
    if (grid < 0) return;
    (void)hipMemsetAsync((char*)d_ws + WS_CTL, 0, CTL_ZERO_BYTES, stream);
    Args a{};
    for (int i = 0; i < 26; ++i) a.in[i] = (const float*)d_in[i];
    a.out = (float*)d_out; a.ws = (unsigned char*)d_ws;
#if MK_PER_PHASE
    for (int p = 0; p < NPHASE; ++p) { a.ph_lo = p; a.ph_hi = p + 1; hipLaunchKernelGGL(mk_fwd, dim3(grid), dim3(NWAVES * 64), LDS_BYTES, stream, a); }
#else
    a.ph_lo = 0; a.ph_hi = NPHASE;
    hipLaunchKernelGGL(mk_fwd, dim3(grid), dim3(NWAVES * 64), LDS_BYTES, stream, a);
#endif
}
```
